# Optimizing an MI355X kernel written in HIP

```python
import math
import jax, jax.numpy as jnp
from jax import lax
import numpy as np

D_MODEL = 2048
BATCH = 1
SEQ = 8192
DEPTH = 1

GRID_W = 64
NORM_EPS = 1e-6
A_HEADS = 4
A_HEAD_DIM = D_MODEL // 8
A_WIDTH = A_HEADS * A_HEAD_DIM
A_CHUNK = 128
CONV_W = 5
B_HEADS = 8
B_KV_HEADS = 2
B_HEAD_DIM = 128
B_WIDTH = B_HEADS * B_HEAD_DIM
B_KV_WIDTH = B_KV_HEADS * B_HEAD_DIM
Q_BLOCK = 128
ROPE_THETA = 10000.0
N_EXPERTS = 32
TOP_K = 4
D_FF = D_MODEL
SWIGLU_LIMIT = 7.0
SWIGLU_ALPHA = 1.702
MOE_BLOCK = 128
SPLITS = (A_WIDTH, A_WIDTH, A_WIDTH, A_WIDTH, 4 * A_HEADS, B_WIDTH, B_KV_WIDTH, B_KV_WIDTH, 2 * D_MODEL)
D_IN = sum(SPLITS)

kernel_name = "hybrid_mlstm_axialgqa_moe_encoder"


def rmsnorm(x, g):
    xf = x.astype(jnp.float32)
    y = xf * lax.rsqrt(jnp.mean(xf * xf, axis=-1, keepdims=True) + NORM_EPS)
    return (y * g.astype(jnp.float32)).astype(x.dtype)


def centred_depthwise_conv(x, w, b):
    y = lax.conv_general_dilated(x, w[:, None, :].astype(x.dtype), window_strides=(1,),
                                 padding=[(CONV_W // 2, CONV_W // 2)],
                                 dimension_numbers=('NWC', 'WIO', 'NWC'),
                                 feature_group_count=x.shape[-1])
    return y + b.astype(x.dtype)


def mlstm_direction(q, k, v, i_pre, f_pre):
    B, H, S, dh = q.shape
    nc = S // A_CHUNK
    q = q * (dh ** -0.5)
    log_f = jax.nn.log_sigmoid(f_pre)

    def chunks(t):
        return jnp.moveaxis(t.reshape(B, H, nc, A_CHUNK, *t.shape[3:]), 2, 0)

    causal = jnp.tril(jnp.ones((A_CHUNK, A_CHUNK), dtype=bool))

    def step(carry, xs):
        C, n, m = carry
        qc, kc, vc, ic, fc = xs
        b = jnp.cumsum(fc, axis=-1)
        d = b[..., :, None] - b[..., None, :] + ic[..., None, :]
        d = jnp.where(causal, d, -jnp.inf)
        m_inter = b + m[..., None]
        m_t = jnp.maximum(m_inter, jnp.max(d, axis=-1))
        w = jnp.exp(d - m_t[..., None]) * jnp.einsum('bhld,bhsd->bhls', qc, kc)
        s_inter = jnp.exp(m_inter - m_t)
        num = jnp.einsum('bhls,bhsd->bhld', w, vc) + s_inter[..., None] * jnp.einsum('bhld,bhde->bhle', qc, C)
        den = jnp.sum(w, axis=-1) + s_inter * jnp.einsum('bhld,bhd->bhl', qc, n)
        h = num / jnp.maximum(jnp.abs(den), jnp.exp(-m_t))[..., None]
        b_last = b[..., -1]
        g = b_last[..., None] - b + ic
        m_new = jnp.maximum(b_last + m, jnp.max(g, axis=-1))
        wk = jnp.exp(g - m_new[..., None])
        decay = jnp.exp(b_last + m - m_new)
        C = decay[..., None, None] * C + jnp.einsum('bhs,bhsd,bhse->bhde', wk, kc, vc)
        n = decay[..., None] * n + jnp.einsum('bhs,bhsd->bhd', wk, kc)
        return (C, n, m_new), h

    init = (jnp.zeros((B, H, dh, dh), jnp.float32), jnp.zeros((B, H, dh), jnp.float32),
            jnp.zeros((B, H), jnp.float32))
    _, h = lax.scan(step, init, (chunks(q), chunks(k), chunks(v), chunks(i_pre), chunks(log_f)))
    return jnp.moveaxis(h, 0, 2).reshape(B, H, S, dh)


def mlstm_branch(qa, ka, va, oa, ga, conv_w, conv_b, b_gates, norm_g):
    B, S, _ = qa.shape
    qk = jax.nn.silu(centred_depthwise_conv(jnp.concatenate([qa, ka], axis=-1), conv_w, conv_b))
    qa, ka = jnp.split(qk, 2, axis=-1)

    def heads(t):
        return t.reshape(B, S, A_HEADS, A_HEAD_DIM).transpose(0, 2, 1, 3).astype(jnp.float32)

    q, k, v = heads(qa), heads(ka), heads(va)
    gates = (ga.reshape(B, S, 4, A_HEADS) + b_gates.astype(ga.dtype)).transpose(2, 0, 3, 1).astype(jnp.float32)
    h_fwd = mlstm_direction(q, k, v, gates[0], gates[1])
    h_bwd = jnp.flip(mlstm_direction(jnp.flip(q, 2), jnp.flip(k, 2), jnp.flip(v, 2),
                                     jnp.flip(gates[2], -1), jnp.flip(gates[3], -1)), 2)
    h = (h_fwd + h_bwd).transpose(0, 2, 1, 3)
    h = rmsnorm(h, norm_g.reshape(A_HEADS, A_HEAD_DIM)).reshape(B, S, A_WIDTH)
    return (jax.nn.sigmoid(oa.astype(jnp.float32)) * h).astype(qa.dtype)


def axial_rope_tables(S):
    rows = S // GRID_W
    row_pos = jnp.repeat(jnp.arange(rows, dtype=jnp.float32), GRID_W)
    col_pos = jnp.tile(jnp.arange(GRID_W, dtype=jnp.float32), rows)
    half = B_HEAD_DIM // 2
    inv_freq = ROPE_THETA ** (-jnp.arange(0, half, 2, dtype=jnp.float32) / half)
    ang_r = row_pos[:, None] * inv_freq
    ang_c = col_pos[:, None] * inv_freq
    return (jnp.cos(ang_r)[:, None, :], jnp.sin(ang_r)[:, None, :],
            jnp.cos(ang_c)[:, None, :], jnp.sin(ang_c)[:, None, :])


def rope_rotate(x, cos, sin):
    x1, x2 = jnp.split(x, 2, axis=-1)
    return jnp.concatenate([x1 * cos - x2 * sin, x1 * sin + x2 * cos], axis=-1)


def apply_axial_rope(x, tables):
    cr, sr, cc, sc = tables
    xf = x.astype(jnp.float32)
    half = B_HEAD_DIM // 2
    y = jnp.concatenate([rope_rotate(xf[..., :half], cr, sr), rope_rotate(xf[..., half:], cc, sc)], axis=-1)
    return y.astype(x.dtype)


def attention_branch(qb, kb, vb, q_norm_g, k_norm_g):
    B, S, _ = qb.shape
    G = B_HEADS // B_KV_HEADS
    tables = axial_rope_tables(S)
    q = apply_axial_rope(rmsnorm(qb.reshape(B, S, B_HEADS, B_HEAD_DIM), q_norm_g), tables)
    k = apply_axial_rope(rmsnorm(kb.reshape(B, S, B_KV_HEADS, B_HEAD_DIM), k_norm_g), tables)
    v = vb.reshape(B, S, B_KV_HEADS, B_HEAD_DIM).transpose(0, 2, 1, 3)
    k = k.transpose(0, 2, 1, 3)
    q = q.reshape(B, S, B_KV_HEADS, G, B_HEAD_DIM).transpose(0, 2, 3, 1, 4)
    nb = S // Q_BLOCK
    q_blocks = jnp.moveaxis(q.reshape(B, B_KV_HEADS, G, nb, Q_BLOCK, B_HEAD_DIM), 3, 0)
    scale = B_HEAD_DIM ** -0.5

    def attend(q_blk):
        s = jnp.einsum('bkgqd,bksd->bkgqs', q_blk, k).astype(jnp.float32) * scale
        p = jax.nn.softmax(s, axis=-1)
        return jnp.einsum('bkgqs,bksd->bkgqd', p.astype(v.dtype), v)

    o = lax.map(attend, q_blocks)
    return o.transpose(1, 0, 4, 2, 3, 5).reshape(B, S, B_WIDTH)


def moe_ffn(x, w_router, b_router, w_gate_up, b_gate_up, w_down, b_down):
    B, S, D = x.shape
    N = B * S
    xt = x.reshape(N, D)
    logits = (xt @ w_router + b_router).astype(jnp.float32)
    top_v, top_i = lax.top_k(logits, TOP_K)
    gate_w = jax.nn.softmax(top_v, axis=-1).astype(x.dtype)
    e_flat = top_i.reshape(-1)
    w_flat = gate_w.reshape(-1)
    tok_flat = jnp.repeat(jnp.arange(N, dtype=jnp.int32), TOP_K)
    order = jnp.argsort(e_flat)
    e_sorted = e_flat[order]
    counts = jnp.zeros((N_EXPERTS,), jnp.int32).at[e_flat].add(1)
    padded = ((counts + MOE_BLOCK - 1) // MOE_BLOCK) * MOE_BLOCK
    pad_end = jnp.cumsum(padded)
    pad_start = pad_end - padded
    start = jnp.cumsum(counts) - counts
    dest = pad_start[e_sorted] + jnp.arange(N * TOP_K, dtype=jnp.int32) - start[e_sorted]
    P = N * TOP_K + N_EXPERTS * MOE_BLOCK
    n_blk = P // MOE_BLOCK
    row_tok = jnp.full((P,), N, jnp.int32).at[dest].set(tok_flat[order])
    row_w = jnp.zeros((P,), x.dtype).at[dest].set(w_flat[order])
    blk_expert = jnp.minimum(jnp.searchsorted(pad_end, jnp.arange(n_blk, dtype=jnp.int32) * MOE_BLOCK, side='right'),
                             N_EXPERTS - 1)
    x_pad = jnp.concatenate([xt, jnp.zeros((1, D), xt.dtype)], axis=0)
    xg = x_pad[row_tok].reshape(n_blk, MOE_BLOCK, D)

    def expert_block(args):
        xb, e = args
        hgu = xb @ w_gate_up[e] + b_gate_up[e]
        gate, up = jnp.split(hgu, 2, axis=-1)
        gate = jnp.minimum(gate, SWIGLU_LIMIT)
        up = jnp.clip(up, -SWIGLU_LIMIT, SWIGLU_LIMIT)
        glu = gate * jax.nn.sigmoid(gate * SWIGLU_ALPHA)
        return ((up + 1.0) * glu) @ w_down[e] + b_down[e]

    yg = lax.map(expert_block, (xg, blk_expert)).reshape(P, D) * row_w[:, None]
    y = jax.ops.segment_sum(yg, row_tok, num_segments=N + 1)[:N]
    return y.reshape(B, S, D)


def setup_inputs(seed: int = 0) -> dict:
    key = jax.random.key(seed)
    ks = jax.random.split(key, 24)
    L, D, E = DEPTH, D_MODEL, N_EXPERTS

    def nrm(k, shape, scale):
        return jax.random.normal(k, shape, jnp.float32) * scale

    def gain(k, shape):
        return 1.0 + 0.05 * jax.random.normal(k, shape, jnp.float32)

    gate_base = jnp.stack([jnp.zeros((A_HEADS,)), jnp.linspace(3.0, 6.0, A_HEADS),
                           jnp.zeros((A_HEADS,)), jnp.linspace(3.0, 6.0, A_HEADS)]).astype(jnp.float32)
    return {
        "x": nrm(ks[0], (BATCH, SEQ, D), 1.0),
        "norm_mix_g": gain(ks[1], (L, D)),
        "w_in": nrm(ks[2], (L, D, D_IN), D ** -0.5),
        "conv_w": nrm(ks[3], (L, CONV_W, 2 * A_WIDTH), CONV_W ** -0.5),
        "conv_b": nrm(ks[4], (L, 2 * A_WIDTH), 0.02),
        "b_mlstm_gates": gate_base[None] + nrm(ks[5], (L, 4, A_HEADS), 0.1),
        "mlstm_norm_g": gain(ks[6], (L, A_WIDTH)),
        "q_norm_g": gain(ks[7], (L, B_HEAD_DIM)),
        "k_norm_g": gain(ks[8], (L, B_HEAD_DIM)),
        "w_proj_a": nrm(ks[9], (L, A_WIDTH, D), A_WIDTH ** -0.5),
        "w_proj_b": nrm(ks[10], (L, B_WIDTH, D), B_WIDTH ** -0.5),
        "w_out": nrm(ks[11], (L, D, D), D ** -0.5),
        "norm_ffn_g": gain(ks[12], (L, D)),
        "w_router": nrm(ks[13], (L, D, E), D ** -0.5),
        "b_router": nrm(ks[14], (L, E), 0.01),
        "w_gate_up": nrm(ks[15], (L, E, D, 2 * D_FF), D ** -0.5),
        "b_gate_up": nrm(ks[16], (L, E, 2 * D_FF), 0.01),
        "w_down": nrm(ks[17], (L, E, D_FF, D), D_FF ** -0.5),
        "b_down": nrm(ks[18], (L, E, D), 0.01),
        "norm_final_g": gain(ks[19], (D,)),
    }


def reference(x, norm_mix_g, w_in, conv_w, conv_b, b_mlstm_gates, mlstm_norm_g, q_norm_g, k_norm_g,
              w_proj_a, w_proj_b, w_out, norm_ffn_g, w_router, b_router, w_gate_up, b_gate_up,
              w_down, b_down, norm_final_g):
    split_idx = [int(s) for s in np.cumsum(SPLITS)[:-1]]
    h = x
    for l in range(DEPTH):
        u = rmsnorm(h, norm_mix_g[l])
        z = u @ w_in[l]
        qa, ka, va, oa, ga, qb, kb, vb, gm = jnp.split(z, split_idx, axis=-1)
        ya = mlstm_branch(qa, ka, va, oa, ga, conv_w[l], conv_b[l], b_mlstm_gates[l], mlstm_norm_g[l])
        yb = attention_branch(qb, kb, vb, q_norm_g[l], k_norm_g[l])
        g_a, g_b = jnp.split(gm, 2, axis=-1)
        mixed = jax.nn.sigmoid(g_a) * (ya @ w_proj_a[l]) + jax.nn.sigmoid(g_b) * (yb @ w_proj_b[l])
        h = h + mixed @ w_out[l]
        h = h + moe_ffn(rmsnorm(h, norm_ffn_g[l]), w_router[l], b_router[l], w_gate_up[l], b_gate_up[l],
                        w_down[l], b_down[l])
    return rmsnorm(h, norm_final_g)
```

```cpp
#include <hip/hip_runtime.h>
#include <hip/hip_bf16.h>
#include <cstdio>
#include <cstdint>

#define GAS __attribute__((address_space(1)))
#define LAS __attribute__((address_space(3)))
typedef unsigned short bf16_t;
typedef short bf16x8 __attribute__((ext_vector_type(8)));
typedef short s16x4 __attribute__((ext_vector_type(4)));
typedef float f32x4 __attribute__((ext_vector_type(4)));
typedef float f32x2 __attribute__((ext_vector_type(2)));
typedef float f32x16 __attribute__((ext_vector_type(16)));
typedef unsigned u32x4 __attribute__((ext_vector_type(4)));
typedef unsigned u32x2 __attribute__((ext_vector_type(2)));
typedef int i32x8 __attribute__((ext_vector_type(8)));

__device__ __forceinline__ unsigned cvt_pk_bf16(float lo, float hi) { unsigned r; asm volatile("v_cvt_pk_bf16_f32 %0, %1, %2" : "=v"(r) : "v"(lo), "v"(hi)); return r; }
__device__ __forceinline__ float bf_lo(unsigned w) { return __uint_as_float(w << 16); }
__device__ __forceinline__ float bf_hi(unsigned w) { return __uint_as_float(w & 0xffff0000u); }
__device__ __forceinline__ float bf2f(bf16_t b) { return __uint_as_float(((unsigned)b) << 16); }
__device__ __forceinline__ bf16_t f2bf(float f) { return (bf16_t)(cvt_pk_bf16(f, 0.f) & 0xffffu); }
__device__ __forceinline__ unsigned cvt4_fp8(float a, float b, float c, float d) { int p = __builtin_amdgcn_cvt_pk_fp8_f32(a, b, 0, false); p = __builtin_amdgcn_cvt_pk_fp8_f32(c, d, p, true); return (unsigned)p; }
__device__ __forceinline__ float sigmoidf_(float x) { return __builtin_amdgcn_rcpf(1.0f + __builtin_amdgcn_exp2f(-1.4426950408889634f * x)); }

__device__ __forceinline__ void mfma_fp8_16x16x128(f32x4& acc, const i32x8& a, const i32x8& b, int unit_scale) {
    asm volatile("v_mfma_scale_f32_16x16x128_f8f6f4 %0, %1, %2, %0, %3, %3 op_sel_hi:[0,0,0]" : "+v"(acc) : "v"(a), "v"(b), "v"(unit_scale));
}
namespace pg8 {
constexpr int BM = 256, BK = 64, HALF = 128, HTB = HALF * BK * 2  , STAGE_BYTES = 8 * HTB, NXCD = 8, WGM = 8;
__host__ __device__ __forceinline__ int lds_byte(int r, int c) { const int st = (r >> 4) * 2 + (c >> 5), rr = r & 15, cc = c & 31, ob = rr * 64 + cc * 2; return st * 1024 + (ob ^ (((ob >> 9) & 1) << 5)); }
__host__ __device__ __forceinline__ void stage_rc(int b, int& R, int& C) { const int st = b / 1024, sb = b % 1024, swz = sb ^ (((sb >> 9) & 1) << 5); R = (st >> 1) * 16 + swz / 64; C = (st & 1) * 32 + (swz % 64) / 2; }
__host__ __device__ __forceinline__ int perm32(int rho) { const int n = rho >> 4, i = rho & 15; return 8 * (i >> 2) + 4 * n + (i & 3); }

struct Unit { int pm, pn, aux; };

__device__ __forceinline__ bool static_tile(int L, int nM, int nN, int& pm, int& pn) {
    const int nwg = nM * nN; if (L >= nwg) return false;
    int wgid = L; { const int q = nwg / NXCD, r = nwg % NXCD, xcd = wgid % NXCD, off = wgid / NXCD; wgid = (xcd < r ? xcd * (q + 1) : r * (q + 1) + (xcd - r) * q) + off; }
    const int nig = WGM * nN, gid = wgid / nig, fm = gid * WGM, gsz = (nM - fm) < WGM ? (nM - fm) : WGM;
    pm = fm + ((wgid % nig) % gsz); pn = (wgid % nig) / gsz; return true;
}

template <class Epi, class Sched, bool FP8 = false>
__device__ __forceinline__ void gemm_phase(LAS unsigned char* lds, const int KB, const Sched& S, const Epi& E) {
    const int tid = threadIdx.x, wid = __builtin_amdgcn_readfirstlane(tid >> 6), lane = tid & 63, wr = wid >> 2, wc = wid & 3, fr = lane & 15, fq = lane >> 4;
    const int nt = KB / 128;
    unsigned voffA[2], voffB[2];
#pragma unroll
    for (int i = 0; i < 2; ++i) { int R, C; stage_rc(tid * 16 + i * 8192, R, C); const int Rb = Epi::PERM ? ((R & ~31) + perm32(R & 31)) : R;
        voffA[i] = (unsigned)(R * KB + C * 2); voffB[i] = (unsigned)(Rb * KB + C * 2); }
    const size_t kstep = (size_t)(BK * 2);
    const size_t hstep = (size_t)HALF * KB;
    const unsigned ldsw = (unsigned)wid * 1024u;
    const int aoff = lds_byte(wr * 64 + fr, fq * 8), boff = lds_byte(wc * 32 + fr, fq * 8);
#define PG8_SA(b, h) (((b) * 2 + (h)) * HTB)
#define PG8_SB(b, h) ((4 + (b) * 2 + (h)) * HTB)
#define PG8_STAGE(bufoff, gbase, voff) do { _Pragma("unroll") for (int _i = 0; _i < 2; ++_i) \
        __builtin_amdgcn_global_load_lds((const unsigned*)((const char*)(gbase) + (voff)[_i]), (LAS unsigned*)(lds + (bufoff) + ldsw + _i * 8192), 16, 0, 0); } while (0)
#define PG8_LDA(dst, b, h) do { if constexpr (FP8) { _Pragma("unroll") for (int m = 0; m < 4; ++m) { const u32x4 lo_ = *(const LAS u32x4*)(lds + PG8_SA(b, h) + aoff + m * 2048), hi_ = *(const LAS u32x4*)(lds + PG8_SA(b, h) + aoff + m * 2048 + 1024); \
            dst##8[m] = (i32x8){(int)lo_.x, (int)lo_.y, (int)lo_.z, (int)lo_.w, (int)hi_.x, (int)hi_.y, (int)hi_.z, (int)hi_.w}; } } \
        else { _Pragma("unroll") for (int m = 0; m < 4; ++m) _Pragma("unroll") for (int k = 0; k < 2; ++k) dst[m][k] = *(const LAS bf16x8*)(lds + PG8_SA(b, h) + aoff + m * 2048 + k * 1024); } } while (0)
#define PG8_LDB(dst, b, h) do { if constexpr (FP8) { _Pragma("unroll") for (int n = 0; n < 2; ++n) { const u32x4 lo_ = *(const LAS u32x4*)(lds + PG8_SB(b, h) + boff + n * 2048), hi_ = *(const LAS u32x4*)(lds + PG8_SB(b, h) + boff + n * 2048 + 1024); \
            dst##8[n] = (i32x8){(int)lo_.x, (int)lo_.y, (int)lo_.z, (int)lo_.w, (int)hi_.x, (int)hi_.y, (int)hi_.z, (int)hi_.w}; } } \
        else { _Pragma("unroll") for (int n = 0; n < 2; ++n) _Pragma("unroll") for (int k = 0; k < 2; ++k) dst[n][k] = *(const LAS bf16x8*)(lds + PG8_SB(b, h) + boff + n * 2048 + k * 1024); } } while (0)
#define PG8_MMA(ai, bj, At, Bt) do { __builtin_amdgcn_s_setprio(1); if constexpr (FP8) { _Pragma("unroll") for (int m = 0; m < 4; ++m) _Pragma("unroll") for (int n = 0; n < 2; ++n) \
            mfma_fp8_16x16x128(acc[ai][bj][m][n], Bt##8[n], At##8[m], unit_scale); } \
        else { _Pragma("unroll") for (int m = 0; m < 4; ++m) _Pragma("unroll") for (int n = 0; n < 2; ++n) _Pragma("unroll") for (int k = 0; k < 2; ++k) \
            acc[ai][bj][m][n] = __builtin_amdgcn_mfma_f32_16x16x32_bf16(Bt[n][k], At[m][k], acc[ai][bj][m][n], 0, 0, 0); } __builtin_amdgcn_s_setprio(0); } while (0)
#define PG8_WAIT_V(n) asm volatile("s_waitcnt vmcnt(" #n ")" ::: "memory")
#define PG8_WAIT_L(n) asm volatile("s_waitcnt lgkmcnt(" #n ")" ::: "memory")
#define PG8_BAR __builtin_amdgcn_s_barrier()
#define PG8_SCHED __builtin_amdgcn_sched_barrier(0)
    Unit cur, nxt; int ui = 0; const int unit_scale = 0x7F7F7F7F;
    if (!S.next(0, cur)) return;
    f32x4 acc[2][2][4][2];
#pragma unroll
    for (int a = 0; a < 2; ++a)
#pragma unroll
        for (int b = 0; b < 2; ++b)
#pragma unroll
            for (int m = 0; m < 4; ++m)
#pragma unroll
                for (int n = 0; n < 2; ++n) acc[a][b][m][n] = (f32x4){0.f, 0.f, 0.f, 0.f};
    typename Epi::Pre pre;
    bf16x8 At[4][2], B0[2][2], B1[2][2]; i32x8 At8[4], B08[2], B18[2];
    const char* cA = S.a_ptr(cur); const char* cB = S.b_ptr(cur);
    PG8_STAGE(PG8_SB(0, 0), cB, voffB); PG8_STAGE(PG8_SB(0, 1), cB + hstep, voffB); PG8_STAGE(PG8_SA(0, 0), cA, voffA); PG8_STAGE(PG8_SA(0, 1), cA + hstep, voffA);
    if (wr == 1) PG8_BAR;
    PG8_WAIT_V(2); PG8_BAR;
    PG8_STAGE(PG8_SB(1, 0), cB + kstep, voffB); PG8_STAGE(PG8_SA(1, 0), cA + kstep, voffA); PG8_STAGE(PG8_SB(1, 1), cB + hstep + kstep, voffB);
    PG8_WAIT_V(6); PG8_BAR;
    for (;;) {
        const bool has_next = S.next(ui + 1, nxt);
        const char* nA = has_next ? S.a_ptr(nxt) : cA; const char* nB = has_next ? S.b_ptr(nxt) : cB;
        for (int t = 0; t < nt; t += 2) {
            const bool last = (t == nt - 2);
            const char* a1 = cA + (size_t)(t + 1) * kstep;
            const char* a2 = last ? nA : cA + (size_t)(t + 2) * kstep; const char* b2 = last ? nB : cB + (size_t)(t + 2) * kstep;
            const char* a3 = a2 + kstep; const char* b3 = b2 + kstep;
            if (last) E.prefetch(pre, cur, wr, wc, fr, fq);
            PG8_LDB(B0, 0, 0); PG8_LDB(B1, 0, 1); PG8_SCHED; PG8_LDA(At, 0, 0); PG8_STAGE(PG8_SA(1, 1), a1 + hstep, voffA);
            PG8_WAIT_V(8); PG8_WAIT_L(0); PG8_BAR; PG8_MMA(0, 0, At, B0); PG8_MMA(0, 1, At, B1); PG8_BAR; PG8_SCHED;
            PG8_LDA(At, 0, 1); PG8_STAGE(PG8_SB(0, 0), b2, voffB); PG8_STAGE(PG8_SB(0, 1), b2 + hstep, voffB); PG8_STAGE(PG8_SA(0, 0), a2, voffA);
            PG8_WAIT_V(8); PG8_WAIT_L(0); PG8_BAR; PG8_MMA(1, 0, At, B0); PG8_MMA(1, 1, At, B1); PG8_BAR; PG8_SCHED;
            PG8_LDB(B0, 1, 0); PG8_LDB(B1, 1, 1); PG8_SCHED; PG8_LDA(At, 1, 0); PG8_STAGE(PG8_SA(0, 1), a2 + hstep, voffA);
            PG8_WAIT_V(8); PG8_WAIT_L(0); PG8_BAR; PG8_MMA(0, 0, At, B0); PG8_MMA(0, 1, At, B1); PG8_BAR; PG8_SCHED;
            PG8_LDA(At, 1, 1); PG8_STAGE(PG8_SB(1, 0), b3, voffB); PG8_STAGE(PG8_SB(1, 1), b3 + hstep, voffB); PG8_STAGE(PG8_SA(1, 0), a3, voffA);
            PG8_WAIT_V(8); PG8_WAIT_L(0); PG8_BAR; PG8_MMA(1, 0, At, B0); PG8_MMA(1, 1, At, B1); PG8_BAR; PG8_SCHED;
        }
        if (wr == 0) PG8_BAR;
        if constexpr (FP8) asm volatile("s_nop 15\n\ts_nop 15" ::: "memory");
        bool keep = false;
        if constexpr (Epi::CHAIN) { keep = (cur.aux == 0); if (keep) E.mid(acc, cur, wr, wc, fr, fq); else E(acc, cur, wr, wc, fr, fq, pre); }
        else E(acc, cur, wr, wc, fr, fq, pre);
        if (!has_next) break;
        if (!keep) {
#pragma unroll
        for (int a = 0; a < 2; ++a)
#pragma unroll
            for (int b = 0; b < 2; ++b)
#pragma unroll
                for (int m = 0; m < 4; ++m)
#pragma unroll
                    for (int n = 0; n < 2; ++n) acc[a][b][m][n] = (f32x4){0.f, 0.f, 0.f, 0.f};
        }
        cur = nxt; cA = nA; cB = nB; ++ui;
        if (wr == 1) PG8_BAR;
    }
    PG8_WAIT_V(0);
    PG8_BAR;
#undef PG8_SA
#undef PG8_SB
#undef PG8_STAGE
#undef PG8_LDA
#undef PG8_LDB
#undef PG8_MMA
#undef PG8_WAIT_V
#undef PG8_WAIT_L
#undef PG8_BAR
#undef PG8_SCHED
}
}
namespace attn {
constexpr int D = 128, NW = 8, QBLK = 32, KVBLK = 64;
constexpr float SCALE = 0.088388347648318440f;
constexpr float THR = 8.f;
constexpr int LDQ = 1024, LDK = 256, LDO = 1024;
constexpr size_t SHM_V = KVBLK * D * 2, SHM_K = KVBLK * D * 2, SHM_ATTN = 2 * SHM_V + 2 * SHM_K + NW * 64 * 4;
#define KSWZ(row, colB) ((row) * 256 + ((colB) ^ (((row) & 7) << 4)))
#define SBAR() __builtin_amdgcn_sched_barrier(0)
__device__ __forceinline__ int crow(int r, int hi) { return (r & 3) + 8 * (r >> 2) + 4 * hi; }
__device__ __forceinline__ unsigned cvtpk(float lo, float hi) { unsigned r; asm volatile("v_cvt_pk_bf16_f32 %0, %1, %2" : "=v"(r) : "v"(lo), "v"(hi)); return r; }

__device__ __forceinline__ void partialSM(f32x16& p0, f32x16& p1, float& m_reg, float& mn, float& alpha) {
  constexpr float C = SCALE * 1.4426950408889634f;
  float pmax = p0[0];
#pragma unroll
  for (int r = 1; r < 16; ++r) pmax = fmaxf(pmax, p0[r]);
#pragma unroll
  for (int r = 0; r < 16; ++r) pmax = fmaxf(pmax, p1[r]);
  { auto rr = __builtin_amdgcn_permlane32_swap(__float_as_uint(pmax), __float_as_uint(pmax), false, false);
    pmax = fmaxf(__uint_as_float(rr[0]), __uint_as_float(rr[1])); }
  if (__builtin_expect(__all(pmax - m_reg <= THR / SCALE), 1)) { mn = m_reg; alpha = 1.f; }
  else { mn = fmaxf(m_reg, pmax); alpha = __builtin_amdgcn_exp2f((m_reg - mn) * C); m_reg = mn; }
  float mnC = -mn * C;
#pragma unroll
  for (int r = 0; r < 16; ++r) p0[r] = fmaf(p0[r], C, mnC);
#pragma unroll
  for (int r = 0; r < 16; ++r) p1[r] = fmaf(p1[r], C, mnC);
#pragma unroll
  for (int r = 0; r < 16; ++r) p0[r] = __builtin_amdgcn_exp2f(p0[r]);
}
__device__ __forceinline__ void finishSM(f32x16& p0, f32x16& p1, float alpha, float& l_reg, bf16x8& pa0, bf16x8& pa1, bf16x8& pa2, bf16x8& pa3) {
#pragma unroll
  for (int r = 0; r < 16; ++r) p1[r] = __builtin_amdgcn_exp2f(p1[r]);
  float ps = 0;
#pragma unroll
  for (int r = 0; r < 16; ++r) ps += p0[r];
#pragma unroll
  for (int r = 0; r < 16; ++r) ps += p1[r];
  { auto rr = __builtin_amdgcn_permlane32_swap(__float_as_uint(ps), __float_as_uint(ps), false, false);
    ps = __uint_as_float(rr[0]) + __uint_as_float(rr[1]); }
  l_reg = l_reg * alpha + ps;
#define PK4(P, BASE, OUT) do { unsigned a0 = cvtpk(P[BASE + 0], P[BASE + 1]), a1 = cvtpk(P[BASE + 2], P[BASE + 3]);   \
    unsigned b0 = cvtpk(P[BASE + 4], P[BASE + 5]), b1 = cvtpk(P[BASE + 6], P[BASE + 7]);                              \
    auto r0 = __builtin_amdgcn_permlane32_swap(a0, b0, false, false); auto r1 = __builtin_amdgcn_permlane32_swap(a1, b1, false, false); \
    u32x4 w = {r0[0], r1[0], r0[1], r1[1]}; OUT = *reinterpret_cast<bf16x8*>(&w); } while (0)
  PK4(p0, 0, pa0); PK4(p0, 8, pa1); PK4(p1, 0, pa2); PK4(p1, 8, pa3);
#undef PK4
}
__device__ __forceinline__ void qkt(f32x16& p0, f32x16& p1, const bf16_t* Ks, const bf16x8* qr, int r32, int hi) {
  p0 = f32x16{}; p1 = f32x16{};
#pragma unroll
  for (int d0 = 0; d0 < 8; ++d0) { int cb = (d0 * 16 + hi * 8) * 2;
    bf16x8 b0 = *reinterpret_cast<const bf16x8*>((const char*)Ks + KSWZ(r32, cb));
    bf16x8 b1 = *reinterpret_cast<const bf16x8*>((const char*)Ks + KSWZ(32 + r32, cb));
    p0 = __builtin_amdgcn_mfma_f32_32x32x16_bf16(b0, qr[d0], p0, 0, 0, 0);
    p1 = __builtin_amdgcn_mfma_f32_32x32x16_bf16(b1, qr[d0], p1, 0, 0, 0); }
}
__device__ __forceinline__ int v_st(int k, int c) { const int kk = (k & ~0xC) | ((k & 4) << 1) | ((k & 8) >> 1); return ((kk >> 3) * 4 + (c >> 5)) * 512 + ((kk & 7) * 32 + (c & 31)) * 2; }
__device__ __forceinline__ int v_rd_base(int lane) { return ((lane & 3) << 3) | (((lane >> 2) & 3) << 6) | (((lane >> 4) & 1) << 5) | (((lane >> 5) & 1) << 8); }
constexpr int v_rd_off(int d0, int ks, int half) { return d0 * 512 + ks * 4096 + half * 2048; }
template <int OFF> __device__ __forceinline__ s16x4 tr_read(int vb) {
  s16x4 r; asm volatile("ds_read_b64_tr_b16 %0, %1 offset:%2" : "=&v"(r) : "v"(vb), "i"(OFF) : "memory"); return r;
}
template <int D0> __device__ __forceinline__ void pv_one(f32x16& od, int vb, bf16x8 pa0, bf16x8 pa1, bf16x8 pa2, bf16x8 pa3) {
  const s16x4 l0 = tr_read<v_rd_off(D0, 0, 0)>(vb), h0 = tr_read<v_rd_off(D0, 0, 1)>(vb), l1 = tr_read<v_rd_off(D0, 1, 0)>(vb), h1 = tr_read<v_rd_off(D0, 1, 1)>(vb);
  const s16x4 l2 = tr_read<v_rd_off(D0, 2, 0)>(vb), h2 = tr_read<v_rd_off(D0, 2, 1)>(vb), l3 = tr_read<v_rd_off(D0, 3, 0)>(vb), h3 = tr_read<v_rd_off(D0, 3, 1)>(vb);
  asm volatile("s_waitcnt lgkmcnt(0)" ::: "memory"); SBAR();
#define PK(L, H) (bf16x8){L[0], L[1], L[2], L[3], H[0], H[1], H[2], H[3]}
  od = __builtin_amdgcn_mfma_f32_32x32x16_bf16(pa0, PK(l0, h0), od, 0, 0, 0);
  od = __builtin_amdgcn_mfma_f32_32x32x16_bf16(pa1, PK(l1, h1), od, 0, 0, 0);
  od = __builtin_amdgcn_mfma_f32_32x32x16_bf16(pa2, PK(l2, h2), od, 0, 0, 0);
  od = __builtin_amdgcn_mfma_f32_32x32x16_bf16(pa3, PK(l3, h3), od, 0, 0, 0);
#undef PK
}
__device__ __forceinline__ void pv_d0(f32x16* o, int vb, bf16x8 pa0, bf16x8 pa1, bf16x8 pa2, bf16x8 pa3) {
  pv_one<0>(o[0], vb, pa0, pa1, pa2, pa3); pv_one<1>(o[1], vb, pa0, pa1, pa2, pa3); pv_one<2>(o[2], vb, pa0, pa1, pa2, pa3); pv_one<3>(o[3], vb, pa0, pa1, pa2, pa3);
}

__device__ __forceinline__ void attn_dense_body(const bf16_t* __restrict__ Qb, const bf16_t* __restrict__ Kh, const bf16_t* __restrict__ Vh, bf16_t* __restrict__ Ob, int seq, char* lds) {
  const int tid = threadIdx.x, wid = tid >> 6, lane = tid & 63, r32 = lane & 31, hi = lane >> 5;
  bf16_t* V_lds = (bf16_t*)lds; bf16_t* K_lds = (bf16_t*)(lds + 2 * SHM_V);
  float* ws = (float*)(lds + 2 * SHM_V + 2 * SHM_K) + wid * 64; float* li_l = ws; float* al_l = ws + 32;
  float m_reg = -1e30f, l_reg = 0; f32x16 o[4] = {}; bf16x8 qr[8];
  const bf16_t* Qw = Qb + (long)(wid * QBLK + r32) * LDQ + hi * 8;
#pragma unroll
  for (int d0 = 0; d0 < 8; ++d0) qr[d0] = *reinterpret_cast<const bf16x8*>(Qw + d0 * 16);
  const int sr = tid >> 4, sc = (tid & 15) * 8, vst0 = v_st(sr, sc), vst1 = v_st(32 + sr, sc);
  const int vb0 = (int)(uintptr_t)V_lds + v_rd_base(lane);
  struct { bf16x8 vs0, vs1, ks0, ks1; } sr_[2];
#define SLOAD(i, k0) do { sr_[i].vs0 = *reinterpret_cast<const bf16x8*>(&Vh[(long)((k0) + sr) * LDK + sc]); sr_[i].vs1 = *reinterpret_cast<const bf16x8*>(&Vh[(long)((k0) + 32 + sr) * LDK + sc]); \
    sr_[i].ks0 = *reinterpret_cast<const bf16x8*>(&Kh[(long)((k0) + sr) * LDK + sc]); sr_[i].ks1 = *reinterpret_cast<const bf16x8*>(&Kh[(long)((k0) + 32 + sr) * LDK + sc]); } while (0)
#define SWRITE(b, i) do { *(bf16x8*)((char*)V_lds + (b) * SHM_V + vst0) = sr_[i].vs0;          \
    *(bf16x8*)((char*)V_lds + (b) * SHM_V + vst1) = sr_[i].vs1; int kc = sc * 2;               \
    *(bf16x8*)((char*)K_lds + (b) * SHM_K + KSWZ(sr, kc)) = sr_[i].ks0;                       \
    *(bf16x8*)((char*)K_lds + (b) * SHM_K + KSWZ(32 + sr, kc)) = sr_[i].ks1; } while (0)
#define SWAIT() asm volatile("s_waitcnt vmcnt(4)" ::: "memory")
#define RESC(a) do { if (__any((a) < 1.f)) { if (hi == 0) al_l[r32] = (a); asm volatile("s_waitcnt lgkmcnt(0)" ::: "memory"); \
    _Pragma("unroll") for (int d = 0; d < 4; ++d) _Pragma("unroll") for (int r = 0; r < 16; ++r) o[d][r] *= al_l[crow(r, hi)]; } } while (0)
  f32x16 pA0, pA1, pB0, pB1; float mnA, mnB, alA, alB; bf16x8 pa0, pa1, pa2, pa3; const int NT = seq / KVBLK;
  constexpr int SE = 0, SO = 1;
  SLOAD(SE, 0); asm volatile("s_waitcnt vmcnt(0)" ::: "memory"); SWRITE(0, SE); __syncthreads();
  qkt(pA0, pA1, K_lds, qr, r32, hi); partialSM(pA0, pA1, m_reg, mnA, alA);
  SLOAD(SO, KVBLK); if (2 < NT) SLOAD(SE, 2 * KVBLK);
  SWAIT(); SWRITE(1, SO); __syncthreads();
  for (int j = 1; j + 1 < NT; j += 2) {
    SBAR(); qkt(pB0, pB1, (bf16_t*)((char*)K_lds + SHM_K), qr, r32, hi);
    finishSM(pA0, pA1, alA, l_reg, pa0, pa1, pa2, pa3); SBAR();
    SLOAD(SO, (j + 2) * KVBLK); SBAR();
    pv_d0(o, vb0, pa0, pa1, pa2, pa3); partialSM(pB0, pB1, m_reg, mnB, alB);
    __syncthreads(); SWAIT(); SWRITE(0, SE);
    RESC(alB); __syncthreads();
    SBAR(); qkt(pA0, pA1, K_lds, qr, r32, hi);
    finishSM(pB0, pB1, alB, l_reg, pa0, pa1, pa2, pa3); SBAR();
    if (j + 3 < NT) SLOAD(SE, (j + 3) * KVBLK); SBAR();
    pv_d0(o, vb0 + (int)SHM_V, pa0, pa1, pa2, pa3); partialSM(pA0, pA1, m_reg, mnA, alA);
    __syncthreads(); SWAIT(); SWRITE(1, SO);
    RESC(alA); __syncthreads();
  }
  SBAR(); qkt(pB0, pB1, (bf16_t*)((char*)K_lds + SHM_K), qr, r32, hi);
  finishSM(pA0, pA1, alA, l_reg, pa0, pa1, pa2, pa3); SBAR();
  pv_d0(o, vb0, pa0, pa1, pa2, pa3); partialSM(pB0, pB1, m_reg, mnB, alB);
  __syncthreads(); RESC(alB);
  finishSM(pB0, pB1, alB, l_reg, pa0, pa1, pa2, pa3); SBAR();
  pv_d0(o, vb0 + (int)SHM_V, pa0, pa1, pa2, pa3);
  if (hi == 0) li_l[r32] = l_reg; asm volatile("s_waitcnt lgkmcnt(0)" ::: "memory");
  float rli[16];
#pragma unroll
  for (int r = 0; r < 16; ++r) rli[r] = __builtin_amdgcn_rcpf(li_l[crow(r, hi)]);
  bf16_t* Ow = Ob + (long)(wid * QBLK) * LDO;
#pragma unroll
  for (int r = 0; r < 16; ++r) { int orow = crow(r, hi);
#pragma unroll
    for (int d0 = 0; d0 < 4; ++d0) Ow[(long)orow * LDO + d0 * 32 + r32] = f2bf(o[d0][r] * rli[r]); }
#undef SLOAD
#undef SWRITE
#undef SWAIT
#undef RESC
}
#undef KSWZ
#undef SBAR
}
constexpr int NWAVES = 8, NTHR = 512;
constexpr int S_ = 8192, DM = 2048;
constexpr int AH = 4, ADH = 256, AW = 1024, ACH = 128, NCH = S_ / ACH;
constexpr int BH = 8, BKV = 2, BDH = 128, BW = 1024, BKW = 256;
constexpr int NE = 32, TOPK = 4, DFF = 2048;
constexpr int D_IN = 9744;
constexpr int ZW = 9728;
constexpr int NIN = 9984;
constexpr int ZC_QA = 0, ZC_KA = 1024, ZC_VA = 2048, ZC_OA = 3072, ZC_QB = 4096, ZC_KB = 5120, ZC_VB = 5376, ZC_GA = 5632, ZC_GB = 7680;
constexpr int PMAX = 40960;
constexpr float NORM_EPS = 1e-6f;
constexpr float W8_SCALE = 128.0f, W8_INV = 1.0f / 128.0f;

constexpr size_t MiB = 1u << 20;
constexpr size_t WS_CTL = 0, CTL_ZERO_BYTES = 1 * MiB;
constexpr size_t WS_WIN = 1 * MiB;
constexpr size_t WS_WPA = WS_WIN + 40 * MiB;
constexpr size_t WS_WPB = WS_WPA + 4 * MiB;
constexpr size_t WS_WOUT = WS_WPB + 4 * MiB;
constexpr size_t WS_WGU = WS_WOUT + 8 * MiB;
constexpr size_t WS_WDN = WS_WGU + 512 * MiB;
constexpr size_t WS_U = WS_WDN + 256 * MiB;
constexpr size_t WS_Z = WS_U + 32 * MiB;
constexpr size_t WS_GATES = WS_Z + 152 * MiB;
constexpr size_t WS_QM = WS_GATES + 1 * MiB;
constexpr size_t WS_KM = WS_QM + 16 * MiB;
constexpr size_t WS_KT = WS_KM + 16 * MiB;
constexpr size_t WS_VT = WS_KT + 16 * MiB;
constexpr size_t WS_QB = WS_VT + 16 * MiB;
constexpr size_t WS_KB = WS_QB + 16 * MiB;
constexpr size_t WS_VB = WS_KB + 4 * MiB;
constexpr size_t WS_GA = WS_VB + 4 * MiB;
constexpr size_t WS_GBV = WS_GA + 1 * MiB;
constexpr size_t WS_GCM = WS_GBV + 1 * MiB;
constexpr size_t WS_CHK = WS_GCM + 1 * MiB;
constexpr size_t WS_CT = WS_CHK + 1 * MiB;
constexpr size_t WS_NS = WS_CT + 64 * MiB;
constexpr size_t WS_YA = WS_NS + 1 * MiB;
constexpr size_t WS_YB = WS_YA + 16 * MiB;
constexpr size_t WS_T = WS_YB + 16 * MiB;
constexpr size_t WS_MIX = WS_T + 64 * MiB;
constexpr size_t WS_H1 = WS_MIX + 32 * MiB;
constexpr size_t WS_TOPI = WS_H1 + 64 * MiB;
constexpr size_t WS_TOPW = WS_TOPI + 1 * MiB;
constexpr size_t WS_SLOT = WS_TOPW + 1 * MiB;
constexpr size_t WS_RASG = WS_SLOT + 1 * MiB;
constexpr size_t WS_RW = WS_RASG + 1 * MiB;
constexpr size_t WS_XG = WS_RW + 1 * MiB;
constexpr size_t WS_ACT = WS_XG + 160 * MiB;
constexpr size_t WS_YS = WS_ACT + 160 * MiB;
constexpr size_t WS_END = WS_YS + 128 * MiB;
constexpr int CW_TMO = 0, CW_CODE = 1;
constexpr int CW_BAR = 4096;
constexpr int CW_CNT = 8192;
constexpr int RING_BYTES = 131072;
constexpr int MISC_OFF = RING_BYTES;
constexpr int TILE_E_OFF = RING_BYTES + 1024;
constexpr int LDS_BYTES = 147456;

typedef GAS unsigned gu32;
#define RLX_AGENT __ATOMIC_RELAXED, __HIP_MEMORY_SCOPE_AGENT
#define LDS_WAIT() asm volatile("s_waitcnt lgkmcnt(0)" ::: "memory")
#define VM_WAIT() asm volatile("s_waitcnt vmcnt(0)" ::: "memory")

#define XB_TMO      128
#define XB_XCNT(j)  (256  + 64 * (j))
#define XB_XSUB(j)  (1280 + 64 * (j))
#define XB_XGEN(j)  (2304 + 64 * (j))
#define XB_TOP      3328
#define XB_TOPGEN   3392
#define XCD_BAR_WORDS 3456
#define XB_SPIN_CAP (1u << 18)

__device__ __forceinline__ unsigned xb_ld(unsigned* p)              { return __hip_atomic_load(p, __ATOMIC_RELAXED, __HIP_MEMORY_SCOPE_AGENT); }
__device__ __forceinline__ unsigned xb_add(unsigned* p, unsigned v) { return __hip_atomic_fetch_add(p, v, __ATOMIC_RELAXED, __HIP_MEMORY_SCOPE_AGENT); }
__device__ __forceinline__ unsigned xb_xcc_id() { return (unsigned)__builtin_amdgcn_s_getreg((3 << 11) | 20) & 0xFu; }
#define XB_SPIN(cond, bar) do { unsigned _sp = 0; while (cond) { __builtin_amdgcn_s_sleep(1); \
    if ((++_sp & 255u) == 0u) { if (xb_ld(&(bar)[XB_TMO])) break; if (_sp > XB_SPIN_CAP) { atomicAdd(&(bar)[XB_TMO], 1u); break; } } } } while (0)

struct XcdBarrier {
    unsigned* bar; unsigned x;
    volatile LAS unsigned* st;
};
__device__ __forceinline__ XcdBarrier xcd_barrier_post(unsigned* bar, volatile LAS unsigned* st) {
    XcdBarrier b; b.bar = bar; b.x = xb_xcc_id(); b.st = st;
    if (threadIdx.x == 0) (void)xb_add(&bar[XB_XCNT(b.x)], 1u);
    return b;
}
__device__ __forceinline__ void xcd_barrier_complete(unsigned* bar, unsigned x, unsigned& nloc, unsigned& nx) {
    const unsigned G = gridDim.x * gridDim.y * gridDim.z;
    unsigned sum, cnt, mine, sp = 0u;
    for (;;) {
        sum = 0u; cnt = 0u; mine = 0u;
#pragma unroll
        for (unsigned j = 0; j < 16; ++j) { const unsigned c = xb_ld(&bar[XB_XCNT(j)]); sum += c; cnt += (c > 0u) ? 1u : 0u; mine = (j == x) ? c : mine; }
        if (sum == G) break;
        __builtin_amdgcn_s_sleep(1);
        if ((++sp & 255u) == 0u) { if (xb_ld(&bar[XB_TMO])) break; if (sp > XB_SPIN_CAP) { atomicAdd(&bar[XB_TMO], 1u); break; } }
    }
    nloc = mine > 0u ? mine : 1u; nx = cnt > 0u ? cnt : 1u;
}
__device__ __forceinline__ void xcd_barrier(const XcdBarrier& b) {
    asm volatile("s_waitcnt vmcnt(0)" ::: "memory");
    __syncthreads();
    if (threadIdx.x == 0) {
        unsigned* bar = b.bar;
        __builtin_amdgcn_s_waitcnt(0);
        unsigned nloc = b.st[0], nx = b.st[1];
        if (nloc == 0u) { xcd_barrier_complete(bar, b.x, nloc, nx); b.st[0] = nloc; b.st[1] = nx; }
        const unsigned old = xb_add(&bar[XB_XSUB(b.x)], 1u);
        const unsigned gen = old / nloc;
        if (old + 1u == (gen + 1u) * nloc) {
            __builtin_amdgcn_fence(__ATOMIC_RELEASE, "agent");
            asm volatile("s_waitcnt vmcnt(0)" ::: "memory");
            const unsigned og = xb_add(&bar[XB_TOP], 1u);
            const unsigned tg = og / nx;
            if (og + 1u == (tg + 1u) * nx) xb_add(&bar[XB_TOPGEN], 1u);
            else XB_SPIN(xb_ld(&bar[XB_TOPGEN]) == tg, bar);
            __builtin_amdgcn_fence(__ATOMIC_ACQUIRE, "agent");
            xb_add(&bar[XB_XGEN(b.x)], 1u);
            asm volatile("s_waitcnt vmcnt(0)" ::: "memory");
        } else {
            XB_SPIN(xb_ld(&bar[XB_XGEN(b.x)]) == gen, bar);
            __builtin_amdgcn_fence(__ATOMIC_ACQUIRE, "agent");
            asm volatile("s_waitcnt vmcnt(0)" ::: "memory");
        }
    }
    __syncthreads();
}

__device__ __forceinline__ float wave_sum(float v) {
#pragma unroll
    for (int o = 1; o < 64; o <<= 1) v += __shfl_xor(v, o);
    return v;
}
__device__ __forceinline__ float wave_max(float v) {
#pragma unroll
    for (int o = 1; o < 64; o <<= 1) v = fmaxf(v, __shfl_xor(v, o));
    return v;
}

struct Frame {
    LAS unsigned char* lds;
    unsigned char* ws;
    gu32* ctl;
    int tid, lane, wave, G, vcu;
    const float* in[20];
    float* out;
};
__device__ __forceinline__ void transpose_item(const float* __restrict__ W, int ldw, int k0, int c0, int valid, bf16_t* __restrict__ WT, int ldt, int r0, LAS unsigned char* scr, int lane) {
    const int kg = lane >> 4, ng = lane & 15;
    const bool ok = 4 * ng < valid;
#pragma unroll
    for (int it = 0; it < 4; ++it) {
        f32x4 v[4];
#pragma unroll
        for (int j = 0; j < 4; ++j) { const int k = k0 + 16 * it + 4 * kg + j; v[j] = ok ? __builtin_nontemporal_load((const f32x4*)(W + (size_t)k * ldw + c0 + 4 * ng)) : (f32x4){0.f, 0.f, 0.f, 0.f}; }
#pragma unroll
        for (int i = 0; i < 4; ++i) { u32x2 p; p.x = cvt_pk_bf16(v[0][i], v[1][i]); p.y = cvt_pk_bf16(v[2][i], v[3][i]);
            *(LAS u32x2*)(scr + (4 * ng + i) * 144 + (16 * it + 4 * kg) * 2) = p; }
    }
    LDS_WAIT(); asm volatile("" ::: "memory");
    const int c = lane & 7;
#pragma unroll
    for (int j2 = 0; j2 < 8; ++j2) { const int n = (lane >> 3) + 8 * j2; const u32x4 o = *(const LAS u32x4*)(scr + n * 144 + c * 16);
        *(u32x4*)(WT + (size_t)(r0 + n) * ldt + k0 + 8 * c) = o; }
    LDS_WAIT(); asm volatile("" ::: "memory");
}

__device__ __forceinline__ void transpose_item8(const float* __restrict__ W, int ldw, int k0, int c0, unsigned char* __restrict__ WT, int ldt, int r0, LAS unsigned char* scr, int lane) {
    const int kg = lane >> 4, ng = lane & 15;
#pragma unroll
    for (int it = 0; it < 8; ++it) {
        f32x4 v[4];
#pragma unroll
        for (int j = 0; j < 4; ++j) { const int k = k0 + 16 * it + 4 * kg + j; v[j] = __builtin_nontemporal_load((const f32x4*)(W + (size_t)k * ldw + c0 + 4 * ng)) * W8_SCALE; }
#pragma unroll
        for (int i = 0; i < 4; ++i) *(LAS unsigned*)(scr + (4 * ng + i) * 144 + (16 * it + 4 * kg)) = cvt4_fp8(v[0][i], v[1][i], v[2][i], v[3][i]);
    }
    LDS_WAIT(); asm volatile("" ::: "memory");
    const int c = lane & 7;
#pragma unroll
    for (int j2 = 0; j2 < 8; ++j2) { const int n = (lane >> 3) + 8 * j2; const u32x4 o = *(const LAS u32x4*)(scr + n * 144 + c * 16);
        __builtin_nontemporal_store(o, (u32x4*)(WT + (size_t)(r0 + n) * ldt + k0 + 16 * c)); }
    LDS_WAIT(); asm volatile("" ::: "memory");
}

struct Item8 { const float* W; unsigned char* WT; int ldw, ldt, k0, c0, r0; };
__device__ __forceinline__ Item8 moe_item8(Frame& F, int r) {
    Item8 t;
    if (r < NE * 64 * 16) { const int e = r / (64 * 16), q = r % (64 * 16), rb = q % 64, kb = q / 64, r0 = 64 * rb, pn = r0 >> 8, rem = r0 & 255, bj = rem >> 7, j0 = rem & 127;
        t.W = F.in[15] + (size_t)e * DM * 4096; t.ldw = 4096; t.k0 = 128 * kb; t.c0 = bj * 2048 + 128 * pn + j0; t.WT = F.ws + WS_WGU + (size_t)e * 4096 * DM; t.ldt = DM; t.r0 = r0; }
    else { r -= NE * 64 * 16; const int e = r / (32 * 16), q = r % (32 * 16), rb = q % 32, kb = q / 32;
        t.W = F.in[17] + (size_t)e * DFF * DM; t.ldw = DM; t.k0 = 128 * kb; t.c0 = 64 * rb; t.WT = F.ws + WS_WDN + (size_t)e * DM * DFF; t.ldt = DFF; t.r0 = 64 * rb; }
    return t;
}
#define HALF8_LOAD(V, T, hf) do { const int kg_ = lane >> 4, ng_ = lane & 15; _Pragma("unroll") for (int it = 0; it < 4; ++it) _Pragma("unroll") for (int j = 0; j < 4; ++j) \
        V[4 * it + j] = *(const f32x4*)((T).W + (size_t)((T).k0 + 64 * (hf) + 16 * it + 4 * kg_ + j) * (T).ldw + (T).c0 + 4 * ng_); } while (0)
#define HALF8_STORE(V, T, hf) do { const int kg_ = lane >> 4, ng_ = lane & 15; _Pragma("unroll") for (int it = 0; it < 4; ++it) _Pragma("unroll") for (int i = 0; i < 4; ++i) \
        *(LAS unsigned*)(scr + (4 * ng_ + i) * 80 + (16 * it + 4 * kg_)) = cvt4_fp8(V[4 * it][i] * W8_SCALE, V[4 * it + 1][i] * W8_SCALE, V[4 * it + 2][i] * W8_SCALE, V[4 * it + 3][i] * W8_SCALE); \
        LDS_WAIT(); asm volatile("" ::: "memory"); const int c_ = lane & 3; \
        _Pragma("unroll") for (int j2 = 0; j2 < 4; ++j2) { const int n = (lane >> 2) + 16 * j2; const u32x4 o = *(const LAS u32x4*)(scr + n * 80 + c_ * 16); \
            *(u32x4*)((T).WT + (size_t)((T).r0 + n) * (T).ldt + (T).k0 + 64 * (hf) + 16 * c_) = o; } \
        LDS_WAIT(); asm volatile("" ::: "memory"); } while (0)

__device__ __forceinline__ void rms_row_to_bf16(const float* __restrict__ xrow, const float* __restrict__ g, bf16_t* __restrict__ orow, int lane) {
    f32x4 v[8]; float s = 0.f;
#pragma unroll
    for (int j = 0; j < 8; ++j) { v[j] = *(const f32x4*)(xrow + 256 * j + 4 * lane); s += (v[j].x * v[j].x + v[j].y * v[j].y) + (v[j].z * v[j].z + v[j].w * v[j].w); }
    const float rstd = 1.0f / sqrtf(wave_sum(s) * (1.f / 2048.f) + NORM_EPS);
#pragma unroll
    for (int j = 0; j < 8; ++j) { const f32x4 gg = *(const f32x4*)(g + 256 * j + 4 * lane); u32x2 w; w.x = cvt_pk_bf16(v[j].x * rstd * gg.x, v[j].y * rstd * gg.y); w.y = cvt_pk_bf16(v[j].z * rstd * gg.z, v[j].w * rstd * gg.w);
        *(u32x2*)(orow + 256 * j + 4 * lane) = w; }
}

constexpr int I_IN = (NIN / 64) * 32, I_GU = NE * 64 * 16, I_DN = NE * 32 * 16, I_PA = 32 * 16, I_OUT = 32 * 32;
constexpr int NITEMS = I_IN + I_GU + I_DN + 2 * I_PA + I_OUT;
#ifndef X_ITEMS
#define X_ITEMS 36864
#endif
constexpr int CONV_PER_XCD = 12;
__device__ __forceinline__ bool is_converter(const Frame& F) { return F.G == 256 && (F.vcu & 31) >= 32 - CONV_PER_XCD; }
__device__ __forceinline__ void conv_item(Frame& F, int it, LAS unsigned char* scr) {
    const float* w_in = F.in[2]; const float* w_pa = F.in[9]; const float* w_pb = F.in[10]; const float* w_out = F.in[11]; const float* w_gu = F.in[15]; const float* w_dn = F.in[17];
    bf16_t* WIN = (bf16_t*)(F.ws + WS_WIN); bf16_t* WPA = (bf16_t*)(F.ws + WS_WPA); bf16_t* WPB = (bf16_t*)(F.ws + WS_WPB); bf16_t* WOUT = (bf16_t*)(F.ws + WS_WOUT);
    unsigned char* WGU = F.ws + WS_WGU; unsigned char* WDN = F.ws + WS_WDN;
    int r = it;
    if (r < I_IN) { const int rb = r / 32, kb = r % 32, r0 = 64 * rb; int c0, valid;
        if (r0 < 4096) { c0 = r0; valid = 64; } else if (r0 < ZW) { c0 = r0 + 16; valid = 64; } else if (r0 == ZW) { c0 = 4096; valid = 16; } else { c0 = 0; valid = 0; }
        transpose_item(w_in, D_IN, 64 * kb, c0, valid, WIN, DM, r0, scr, F.lane); return; }
    r -= I_IN;
    if (r < I_GU) { const int e = r / (64 * 16), q = r % (64 * 16), rb = q % 64, kb = q / 64, r0 = 64 * rb, pn = r0 >> 8, rem = r0 & 255, bj = rem >> 7, j0 = rem & 127;
        transpose_item8(w_gu + (size_t)e * DM * 4096, 4096, 128 * kb, bj * 2048 + 128 * pn + j0, WGU + (size_t)e * 4096 * DM, DM, r0, scr, F.lane); return; }
    r -= I_GU;
    if (r < I_DN) { const int e = r / (32 * 16), q = r % (32 * 16), rb = q % 32, kb = q / 32;
        transpose_item8(w_dn + (size_t)e * DFF * DM, DM, 128 * kb, 64 * rb, WDN + (size_t)e * DM * DFF, DFF, 64 * rb, scr, F.lane); return; }
    r -= I_DN;
    if (r < I_PA) { const int rb = r / 16, kb = r % 16; transpose_item(w_pa, DM, 64 * kb, 64 * rb, 64, WPA, AW, 64 * rb, scr, F.lane); return; }
    r -= I_PA;
    if (r < I_PA) { const int rb = r / 16, kb = r % 16; transpose_item(w_pb, DM, 64 * kb, 64 * rb, 64, WPB, BW, 64 * rb, scr, F.lane); return; }
    r -= I_PA;
    { const int rb = r / 32, kb = r % 32; transpose_item(w_out, DM, 64 * kb, 64 * rb, 64, WOUT, DM, 64 * rb, scr, F.lane); }
}
__device__ __forceinline__ void p0_prologue(Frame& F) {
    LAS unsigned char* scr = F.lds + F.wave * 9216;
    const int gw = F.vcu * NWAVES + F.wave, NGW = F.G * NWAVES;
    const int xi = (F.G == 256) ? X_ITEMS : 0;
    for (int j = gw; j < NITEMS - xi; j += NGW) conv_item(F, j < I_IN ? j : j + xi, scr);
    bf16_t* U = (bf16_t*)(F.ws + WS_U);
    for (int m = gw; m < S_; m += NGW) rms_row_to_bf16(F.in[0] + (size_t)m * DM, F.in[1], U + (size_t)m * DM, F.lane);
    int* rasg = (int*)(F.ws + WS_RASG); float* rw = (float*)(F.ws + WS_RW);
    for (int i = gw * 64 + F.lane; i < PMAX; i += NGW * 64) { rasg[i] = -1; rw[i] = 0.f; }
}
__device__ __forceinline__ void p1_convert(Frame& F) {
    LAS unsigned char* scr = F.lds + F.wave * 9216;
    const int cr = (F.vcu >> 5) * CONV_PER_XCD + ((F.vcu & 31) - (32 - CONV_PER_XCD));
    for (int j = cr * NWAVES + F.wave; j < X_ITEMS; j += 8 * CONV_PER_XCD * NWAVES) conv_item(F, I_IN + j, scr);
}

__device__ __forceinline__ void p2a_mlstm_prep(Frame& F) {
    const int gw = F.vcu * NWAVES + F.wave, NGW = F.G * NWAVES, lane = F.lane;
    const bf16_t* Z = (const bf16_t*)(F.ws + WS_Z);
    bf16_t* QM = (bf16_t*)(F.ws + WS_QM); bf16_t* KM = (bf16_t*)(F.ws + WS_KM); bf16_t* KT = (bf16_t*)(F.ws + WS_KT); bf16_t* VT = (bf16_t*)(F.ws + WS_VT);
    const float* conv_w = F.in[3]; const float* conv_b = F.in[4];
    const int cg = lane & 7, tg = lane >> 3;
    for (int it = gw; it < 48 * 128; it += NGW) {
        const int cb = it % 48, tb = it / 48;
        const int ch = 64 * cb + 8 * cg;
        const int t0 = 64 * tb + 8 * tg;
        float y[8][8];
        if (cb < 32) {
            float x[12][8];
#pragma unroll
            for (int r = 0; r < 12; ++r) { const int t = t0 + r - 2;
                if (t >= 0 && t < S_) { const u32x4 w = *(const u32x4*)(Z + (size_t)t * ZW + ch);
                    x[r][0] = bf_lo(w.x); x[r][1] = bf_hi(w.x); x[r][2] = bf_lo(w.y); x[r][3] = bf_hi(w.y); x[r][4] = bf_lo(w.z); x[r][5] = bf_hi(w.z); x[r][6] = bf_lo(w.w); x[r][7] = bf_hi(w.w); }
                else {
#pragma unroll
                    for (int c = 0; c < 8; ++c) x[r][c] = 0.f; } }
            float cw[5][8], cbv[8];
#pragma unroll
            for (int j = 0; j < 5; ++j) { const f32x4 a = *(const f32x4*)(conv_w + j * 2048 + ch), b = *(const f32x4*)(conv_w + j * 2048 + ch + 4);
                cw[j][0] = a.x; cw[j][1] = a.y; cw[j][2] = a.z; cw[j][3] = a.w; cw[j][4] = b.x; cw[j][5] = b.y; cw[j][6] = b.z; cw[j][7] = b.w; }
            { const f32x4 a = *(const f32x4*)(conv_b + ch), b = *(const f32x4*)(conv_b + ch + 4); cbv[0] = a.x; cbv[1] = a.y; cbv[2] = a.z; cbv[3] = a.w; cbv[4] = b.x; cbv[5] = b.y; cbv[6] = b.z; cbv[7] = b.w; }
            const float osc = (cb < 16) ? 0.0625f : 1.0f;
#pragma unroll
            for (int t = 0; t < 8; ++t)
#pragma unroll
                for (int c = 0; c < 8; ++c) { float s = cbv[c];
#pragma unroll
                    for (int j = 0; j < 5; ++j) s = fmaf(cw[j][c], x[t + j][c], s);
                    y[t][c] = s * sigmoidf_(s) * osc; }
            bf16_t* RM = (cb < 16) ? (QM + ch) : (KM + (ch - 1024));
#pragma unroll
            for (int t = 0; t < 8; ++t) { u32x4 w; w.x = cvt_pk_bf16(y[t][0], y[t][1]); w.y = cvt_pk_bf16(y[t][2], y[t][3]); w.z = cvt_pk_bf16(y[t][4], y[t][5]); w.w = cvt_pk_bf16(y[t][6], y[t][7]);
                *(u32x4*)(RM + (size_t)(t0 + t) * AW) = w; }
        } else {
#pragma unroll
            for (int t = 0; t < 8; ++t) { const u32x4 w = *(const u32x4*)(Z + (size_t)(t0 + t) * ZW + ch);
                y[t][0] = bf_lo(w.x); y[t][1] = bf_hi(w.x); y[t][2] = bf_lo(w.y); y[t][3] = bf_hi(w.y); y[t][4] = bf_lo(w.z); y[t][5] = bf_hi(w.z); y[t][6] = bf_lo(w.w); y[t][7] = bf_hi(w.w); }
        }
        if (cb >= 16) {
            bf16_t* TT = (cb < 32) ? (KT + (size_t)(ch - 1024) * S_) : (VT + (size_t)(ch - 2048) * S_);
#pragma unroll
            for (int c = 0; c < 8; ++c) { u32x4 w; w.x = cvt_pk_bf16(y[0][c], y[1][c]); w.y = cvt_pk_bf16(y[2][c], y[3][c]); w.z = cvt_pk_bf16(y[4][c], y[5][c]); w.w = cvt_pk_bf16(y[6][c], y[7][c]);
                *(u32x4*)(TT + (size_t)c * S_ + t0) = w; }
        }
    }
}

__device__ __forceinline__ void p2b_attn_prep(Frame& F) {
    const int gw = F.vcu * NWAVES + F.wave, NGW = F.G * NWAVES, lane = F.lane, j2 = 2 * (lane & 15);
    const bf16_t* Z = (const bf16_t*)(F.ws + WS_Z);
    bf16_t* QB = (bf16_t*)(F.ws + WS_QB); bf16_t* KB = (bf16_t*)(F.ws + WS_KB); bf16_t* VB = (bf16_t*)(F.ws + WS_VB);
    const float* qg = F.in[7]; const float* kg = F.in[8];
    const float if0 = exp2f(-(float)j2 * (13.287712379549449f / 32.0f)), if1 = exp2f(-(float)(j2 + 1) * (13.287712379549449f / 32.0f));
    float gq[8], gk[8];
#pragma unroll
    for (int qd = 0; qd < 4; ++qd) { gq[2 * qd] = qg[32 * qd + j2]; gq[2 * qd + 1] = qg[32 * qd + j2 + 1]; gk[2 * qd] = kg[32 * qd + j2]; gk[2 * qd + 1] = kg[32 * qd + j2 + 1]; }
    for (int t = 4 * gw + (lane >> 4); t < S_; t += 4 * NGW) {
        const float pr = (float)(t >> 6), pc = (float)(t & 63);
        float cr0, sr0, cr1, sr1, cc0, sc0, cc1, sc1;
        sincosf(pr * if0, &sr0, &cr0); sincosf(pr * if1, &sr1, &cr1); sincosf(pc * if0, &sc0, &cc0); sincosf(pc * if1, &sc1, &cc1);
        const bf16_t* zr = Z + (size_t)t * ZW;
        unsigned raw[10][4];
#pragma unroll
        for (int j = 0; j < 10; ++j) { const bf16_t* src = (j < 8) ? (zr + ZC_QB + 128 * j) : (zr + ZC_KB + 128 * (j - 8));
#pragma unroll
            for (int qd = 0; qd < 4; ++qd) raw[j][qd] = *(const unsigned*)(src + 32 * qd + j2); }
        const u32x4 vv = *(const u32x4*)(zr + ZC_VB + 8 * (lane & 15)), vv2 = *(const u32x4*)(zr + ZC_VB + 128 + 8 * (lane & 15));
#pragma unroll
        for (int j = 0; j < 10; ++j) {
            float x[8];
#pragma unroll
            for (int qd = 0; qd < 4; ++qd) { x[2 * qd] = bf_lo(raw[j][qd]); x[2 * qd + 1] = bf_hi(raw[j][qd]); }
            float ss = 0.f;
#pragma unroll
            for (int i = 0; i < 8; ++i) ss = fmaf(x[i], x[i], ss);
            ss += __shfl_xor(ss, 1); ss += __shfl_xor(ss, 2); ss += __shfl_xor(ss, 4); ss += __shfl_xor(ss, 8);
            const float rstd = __builtin_amdgcn_rsqf(ss * (1.f / 128.f) + NORM_EPS);
#pragma unroll
            for (int i = 0; i < 8; ++i) x[i] *= rstd * ((j < 8) ? gq[i] : gk[i]);
            const float o00 = x[0] * cr0 - x[2] * sr0, o01 = x[1] * cr1 - x[3] * sr1, o10 = x[0] * sr0 + x[2] * cr0, o11 = x[1] * sr1 + x[3] * cr1;
            const float o20 = x[4] * cc0 - x[6] * sc0, o21 = x[5] * cc1 - x[7] * sc1, o30 = x[4] * sc0 + x[6] * cc0, o31 = x[5] * sc1 + x[7] * cc1;
            bf16_t* dst = (j < 8) ? (QB + (size_t)t * BW + 128 * j) : (KB + (size_t)t * BKW + 128 * (j - 8));
            *(unsigned*)(dst + j2) = cvt_pk_bf16(o00, o01); *(unsigned*)(dst + 32 + j2) = cvt_pk_bf16(o10, o11); *(unsigned*)(dst + 64 + j2) = cvt_pk_bf16(o20, o21); *(unsigned*)(dst + 96 + j2) = cvt_pk_bf16(o30, o31);
        }
        *(u32x4*)(VB + (size_t)t * BKW + 8 * (lane & 15)) = vv; *(u32x4*)(VB + (size_t)t * BKW + 128 + 8 * (lane & 15)) = vv2;
    }
}

__device__ __forceinline__ float log_sigmoid_(float x) { return fminf(x, 0.f) - log1pf(__expf(-fabsf(x))); }
__device__ __forceinline__ void p2c_gate_prep(Frame& F) {
    const int gw = F.vcu * NWAVES + F.wave, NGW = F.G * NWAVES, lane = F.lane;
    const float* GT = (const float*)(F.ws + WS_GATES); const float* bg = F.in[5];
    float* GA = (float*)(F.ws + WS_GA); float* GBV = (float*)(F.ws + WS_GBV); float* GCM = (float*)(F.ws + WS_GCM);
    float* BC = (float*)(F.ws + WS_CHK); float* AMAX = BC + 512;
    for (int task = gw; task < 4 * NCH * 8; task += NGW) {
        if (task & 3) continue;
        const int c = (task >> 2) >> 3, dir = ((task >> 2) >> 2) & 1, h = (task >> 2) & 3;
        const int t0 = ACH * c + 2 * lane;
            {
                const int gi = dir * 8 + h, gf = dir * 8 + 4 + h;
                const float i0 = GT[(size_t)t0 * 16 + gi] + bg[gi], i1 = GT[(size_t)(t0 + 1) * 16 + gi] + bg[gi];
                const float l0 = log_sigmoid_(GT[(size_t)t0 * 16 + gf] + bg[gf]), l1 = log_sigmoid_(GT[(size_t)(t0 + 1) * 16 + gf] + bg[gf]);
                float tot = l0 + l1, sc = tot;
#pragma unroll
                for (int o = 1; o < 64; o <<= 1) { const float v = dir ? __shfl_down(sc, o) : __shfl_up(sc, o); if (dir ? (lane + o < 64) : (lane >= o)) sc += v; }
                const float ex = sc - tot;
                float b0, b1;
                if (dir == 0) { b0 = ex + l0; b1 = ex + l0 + l1; } else { b1 = ex + l1; b0 = ex + l1 + l0; }
                const float a0 = i0 - b0, a1 = i1 - b1;
                float mx = fmaxf(a0, a1), sm = mx;
#pragma unroll
                for (int o = 1; o < 64; o <<= 1) { const float v = dir ? __shfl_down(sm, o) : __shfl_up(sm, o); if (dir ? (lane + o < 64) : (lane >= o)) sm = fmaxf(sm, v); }
                float exm = dir ? __shfl_down(sm, 1) : __shfl_up(sm, 1); if (dir ? (lane == 63) : (lane == 0)) exm = -3.0e38f;
                float c0, c1;
                if (dir == 0) { c0 = fmaxf(exm, a0); c1 = fmaxf(c0, a1); } else { c1 = fmaxf(exm, a1); c0 = fmaxf(c1, a0); }
                const size_t o = (size_t)(dir * 4 + h) * S_ + t0;
                *(f32x2*)(GA + o) = (f32x2){a0, a1}; *(f32x2*)(GBV + o) = (f32x2){b0, b1}; *(f32x2*)(GCM + o) = (f32x2){c0, c1};
                const float btot = wave_sum(tot), amax = wave_max(mx);
                if (lane == 0) { BC[(dir * 4 + h) * NCH + c] = btot; AMAX[(dir * 4 + h) * NCH + c] = amax; }
            }
    }
}

constexpr int P3_WK = 0, P3_MC = 32768, P3_DEC = 33024, P3_KS = 33280, P3_KSB = 32 * 272;
#define P3_LOAD(AV, KR, c_) do { const int s0_ = ACH * (c_); _Pragma("unroll") for (int ks = 0; ks < 4; ++ks) AV[ks] = *(const bf16x8*)(vrow + s0_ + 32 * ks); KR = *(const u32x4*)(krow + s0_); } while (0)
#define P3_STEP(AV, KR, c_, buf_) do { const int cc = (c_); const float decay = decl[cc]; \
        { const LAS float* wp = wkl + ACH * cc + 8 * sg; const f32x4 g0 = *(const LAS f32x4*)wp, g1 = *(const LAS f32x4*)(wp + 4); const u32x4 kw = KR; \
          const float k0 = bf_lo(kw.x) * g0.x, k1 = bf_hi(kw.x) * g0.y, k2 = bf_lo(kw.y) * g0.z, k3 = bf_hi(kw.y) * g0.w, k4 = bf_lo(kw.z) * g1.x, k5 = bf_hi(kw.z) * g1.y, k6 = bf_lo(kw.w) * g1.z, k7 = bf_hi(kw.w) * g1.w; \
          u32x4 bw; bw.x = cvt_pk_bf16(k0, k1); bw.y = cvt_pk_bf16(k2, k3); bw.z = cvt_pk_bf16(k4, k5); bw.w = cvt_pk_bf16(k6, k7); \
          *(LAS u32x4*)(F.lds + P3_KS + (buf_) * P3_KSB + dd * 272 + sg * 16) = bw; \
          if (et == 0) { float ns = ((k0 + k1) + (k2 + k3)) + ((k4 + k5) + (k6 + k7)); ns += __shfl_xor(ns, 1); ns += __shfl_xor(ns, 2); ns += __shfl_xor(ns, 4); ns += __shfl_xor(ns, 8); \
              if (sg == 0) NS[(size_t)(dh * NCH + cc) * 256 + 32 * dt + dd] = nacc; nacc = nacc * decay + ns; } } \
        bf16_t* ct = CT + ((size_t)(dh * NCH + cc) * 256 + e0 + 4 * kq) * 256 + d0 + cI; \
        _Pragma("unroll") for (int r = 0; r < 4; ++r) __builtin_nontemporal_store(f2bf(acc[r]), ct + (size_t)r * 256);     \
        acc *= decay; \
        asm volatile("s_waitcnt lgkmcnt(0)" ::: "memory"); __builtin_amdgcn_s_barrier(); asm volatile("" ::: "memory"); \
        _Pragma("unroll") for (int ks = 0; ks < 4; ++ks) { const bf16x8 bfr = *(const LAS bf16x8*)(F.lds + P3_KS + (buf_) * P3_KSB + (16 * (F.wave & 1) + cI) * 272 + ks * 64 + kq * 16); \
            acc = __builtin_amdgcn_mfma_f32_16x16x32_bf16(AV[ks], bfr, acc, 0, 0, 0); } } while (0)
__device__ __forceinline__ void p3_state_scan(Frame& F) {
    const int lane = F.lane, cI = lane & 15, kq = lane >> 4, dd = F.tid >> 4, sg = F.tid & 15;
    const bf16_t* KT = (const bf16_t*)(F.ws + WS_KT); const bf16_t* VT = (const bf16_t*)(F.ws + WS_VT);
    const float* GA = (const float*)(F.ws + WS_GA);
    const float* BC = (const float*)(F.ws + WS_CHK); const float* AMAX = BC + 512; float* MS = (float*)(F.ws + WS_CHK) + 1024;
    bf16_t* CT = (bf16_t*)(F.ws + WS_CT); float* NS = (float*)(F.ws + WS_NS);
    LAS float* wkl = (LAS float*)(F.lds + P3_WK); LAS float* mcl = (LAS float*)(F.lds + P3_MC); LAS float* decl = (LAS float*)(F.lds + P3_DEC);
    for (int pi = F.vcu; pi < 256; pi += F.G) {
        const int dh = pi >> 5, dir = dh >> 2, h = dh & 3;
        if (F.wave == 0) {
            const int c = dir ? (NCH - 1 - lane) : lane;
            const float amax = AMAX[dh * NCH + c]; float P = BC[dh * NCH + c], Q = amax + P;
#pragma unroll
            for (int o = 1; o < 64; o <<= 1) { const float Pp = __shfl_up(P, o), Qp = __shfl_up(Q, o); if (lane >= o) { Q = fmaxf(Qp + P, Q); P = Pp + P; } }
            const float mout = fmaxf(P, Q);
            float min_ = __shfl_up(mout, 1); if (lane == 0) min_ = 0.f;
            const float Mc = fmaxf(min_, amax);
            mcl[c] = Mc; decl[c] = __expf(min_ - Mc);
            if ((pi & 31) == 0) MS[dh * NCH + c] = min_;
        }
        __syncthreads();
        { const float* ga = GA + (size_t)dh * S_;
#pragma unroll
          for (int i = 0; i < 16; ++i) { const int s = F.tid + 512 * i; wkl[s] = __expf(ga[s] - mcl[s >> 7]); } }
        __syncthreads();
        {
            const int et = (pi >> 3) & 3, dt = pi & 7, e0 = 64 * et + 16 * (F.wave >> 1), d0 = 32 * dt + 16 * (F.wave & 1);
            const bf16_t* vrow = VT + (size_t)(h * 256 + e0 + cI) * S_ + 8 * kq;
            const bf16_t* krow = KT + (size_t)(h * 256 + 32 * dt + dd) * S_ + 8 * sg;
            f32x4 acc = (f32x4){0.f, 0.f, 0.f, 0.f}; float nacc = 0.f;
            bf16x8 av0[4], av1[4], av2[4], av3[4]; u32x4 kr0, kr1, kr2, kr3;
#define P3_C(st_) (dir ? (NCH - 1 - (st_)) : (st_))
            P3_LOAD(av0, kr0, P3_C(0)); P3_LOAD(av1, kr1, P3_C(1)); P3_LOAD(av2, kr2, P3_C(2));
            for (int st = 0; st < NCH; st += 4) {
                P3_LOAD(av3, kr3, P3_C(st + 3));
                P3_STEP(av0, kr0, P3_C(st), 0);
                if (st + 4 < NCH) P3_LOAD(av0, kr0, P3_C(st + 4));
                P3_STEP(av1, kr1, P3_C(st + 1), 1);
                if (st + 4 < NCH) P3_LOAD(av1, kr1, P3_C(st + 5));
                P3_STEP(av2, kr2, P3_C(st + 2), 0);
                if (st + 4 < NCH) P3_LOAD(av2, kr2, P3_C(st + 6));
                P3_STEP(av3, kr3, P3_C(st + 3), 1);
            }
#undef P3_C
        }
        __syncthreads();
    }
}
#undef P3_LOAD
#undef P3_STEP
constexpr int ML_QL = 0, ML_KL = 65536, ML_ALF = RING_BYTES + 2048, ML_ALB = ML_ALF + 512, ML_RSTD = ML_ALB + 512, ML_SSP = RING_BYTES + 4096, ML_NL = RING_BYTES + 12288;
__device__ __forceinline__ void mlstm_out_unit(Frame& F, int h, int c) {
    const int lane = F.lane, w = F.wave, tid = F.tid, cI = lane & 15, kq = lane >> 4;
    const bf16_t* QM = (const bf16_t*)(F.ws + WS_QM); const bf16_t* KM = (const bf16_t*)(F.ws + WS_KM); const bf16_t* VT = (const bf16_t*)(F.ws + WS_VT);
    const float* GA = (const float*)(F.ws + WS_GA); const float* GBV = (const float*)(F.ws + WS_GBV); const float* GCM = (const float*)(F.ws + WS_GCM);
    const float* MS = (const float*)(F.ws + WS_CHK) + 1024;
    const bf16_t* CT = (const bf16_t*)(F.ws + WS_CT); const float* NS = (const float*)(F.ws + WS_NS);
    LAS unsigned char* QL = F.lds + ML_QL; LAS unsigned char* KL = F.lds + ML_KL; LAS unsigned char* PL = F.lds + ML_KL;
    LAS float* alfl = (LAS float*)(F.lds + ML_ALF); LAS float* albl = (LAS float*)(F.lds + ML_ALB); LAS float* rstdl = (LAS float*)(F.lds + ML_RSTD); LAS float* sspl = (LAS float*)(F.lds + ML_SSP);
    const int t0 = ACH * c;
    int aq[8], ap[4];
#pragma unroll
    for (int ks = 0; ks < 8; ++ks) aq[ks] = cI * 512 + (((4 * ks + kq) ^ cI) << 4);
#pragma unroll
    for (int k2 = 0; k2 < 4; ++k2) ap[k2] = cI * 272 + 64 * k2 + 16 * kq;
    {
        u32x4 qv[8], kv[8];
#pragma unroll
        for (int j = 0; j < 8; ++j) { const int p = tid + 512 * j, row = p >> 5, ch = p & 31;
            qv[j] = *(const u32x4*)(QM + (size_t)(t0 + row) * AW + h * ADH + 8 * ch); kv[j] = *(const u32x4*)(KM + (size_t)(t0 + row) * AW + h * ADH + 8 * ch); }
#pragma unroll
        for (int j = 0; j < 8; ++j) { const int p = tid + 512 * j, row = p >> 5, ch = p & 31, off = row * 512 + ((ch ^ (row & 15)) << 4);
            *(LAS u32x4*)(QL + off) = qv[j]; *(LAS u32x4*)(KL + off) = kv[j]; }
    }
    LAS float* nl = (LAS float*)(F.lds + ML_NL);
    if (tid < 128) { const int dir = tid >> 6, i4 = (tid & 63) * 4; *(LAS f32x4*)(nl + dir * 256 + i4) = *(const f32x4*)(NS + (size_t)((dir * 4 + h) * NCH + c) * 256 + i4); }
    float Mt[2][4], bt[2][4], mc[2], gaf[8], gab[8];
#pragma unroll
    for (int dir = 0; dir < 2; ++dir) { const int dh = dir * 4 + h; mc[dir] = MS[dh * NCH + c]; const size_t go = (size_t)dh * S_ + t0 + 16 * w + 4 * kq;
        const f32x4 cm = *(const f32x4*)(GCM + go), bb = *(const f32x4*)(GBV + go);
#pragma unroll
        for (int r = 0; r < 4; ++r) { Mt[dir][r] = fmaxf(mc[dir], cm[r]); bt[dir][r] = bb[r]; } }
#pragma unroll
    for (int sb = 0; sb < 8; ++sb) { gaf[sb] = GA[(size_t)h * S_ + t0 + 16 * sb + cI]; gab[sb] = GA[(size_t)(4 + h) * S_ + t0 + 16 * sb + cI]; }
    __syncthreads();
    bf16x8 qf[8];
#pragma unroll
    for (int ks = 0; ks < 8; ++ks) qf[ks] = *(const LAS bf16x8*)(QL + w * 8192 + aq[ks]);
    float qn[2];
#pragma unroll
    for (int dir = 0; dir < 2; ++dir) { float s = 0.f;
#pragma unroll
        for (int ks = 0; ks < 8; ++ks) { const f32x4 n0 = *(const LAS f32x4*)(nl + dir * 256 + 32 * ks + 8 * kq), n1 = *(const LAS f32x4*)(nl + dir * 256 + 32 * ks + 8 * kq + 4); const u32x4 qw = __builtin_bit_cast(u32x4, qf[ks]);
            s += bf_lo(qw.x) * n0.x + bf_hi(qw.x) * n0.y + bf_lo(qw.y) * n0.z + bf_hi(qw.y) * n0.w + bf_lo(qw.z) * n1.x + bf_hi(qw.z) * n1.y + bf_lo(qw.w) * n1.z + bf_hi(qw.w) * n1.w; }
        s += __shfl_xor(s, 16); s += __shfl_xor(s, 32); qn[dir] = s; }
    __builtin_amdgcn_sched_barrier(0);
    float wf[8][4], wb[8][4], rsf[4] = {0.f, 0.f, 0.f, 0.f}, rsb[4] = {0.f, 0.f, 0.f, 0.f};
#pragma unroll
    for (int sb = 0; sb < 8; ++sb) {
        f32x4 sa = (f32x4){0.f, 0.f, 0.f, 0.f};
#pragma unroll
        for (int ks = 0; ks < 8; ++ks) { const bf16x8 kf = *(const LAS bf16x8*)(KL + sb * 8192 + aq[ks]); sa = __builtin_amdgcn_mfma_f32_16x16x32_bf16(qf[ks], kf, sa, 0, 0, 0); }
        const int sc = 16 * sb + cI;
#pragma unroll
        for (int r = 0; r < 4; ++r) { const int tr = 16 * w + 4 * kq + r;
            const float vf = (sc <= tr) ? __expf(gaf[sb] - Mt[0][r]) * sa[r] : 0.f, vb = (sc >= tr) ? __expf(gab[sb] - Mt[1][r]) * sa[r] : 0.f;
            wf[sb][r] = vf; wb[sb][r] = vb; rsf[r] += vf; rsb[r] += vb; }
        __builtin_amdgcn_sched_barrier(0);
    }
    float invf[4], invb[4];
#pragma unroll
    for (int r = 0; r < 4; ++r) {
        const float qnf = __shfl(qn[0], 4 * kq + r), qnb = __shfl(qn[1], 4 * kq + r);
        float s = rsf[r]; s += __shfl_xor(s, 1); s += __shfl_xor(s, 2); s += __shfl_xor(s, 4); s += __shfl_xor(s, 8);
        float sint = __expf(mc[0] - Mt[0][r]); float den = s + sint * qnf; float N = fmaxf(fabsf(den), __expf(-(bt[0][r] + Mt[0][r]))); invf[r] = 1.0f / N; const float af = sint * invf[r];
        s = rsb[r]; s += __shfl_xor(s, 1); s += __shfl_xor(s, 2); s += __shfl_xor(s, 4); s += __shfl_xor(s, 8);
        sint = __expf(mc[1] - Mt[1][r]); den = s + sint * qnb; N = fmaxf(fabsf(den), __expf(-(bt[1][r] + Mt[1][r]))); invb[r] = 1.0f / N; const float ab = sint * invb[r];
        if (cI == 0) { alfl[16 * w + 4 * kq + r] = af; albl[16 * w + 4 * kq + r] = ab; } }
    __syncthreads();
#pragma unroll
    for (int sb = 0; sb < 8; ++sb)
#pragma unroll
        for (int r = 0; r < 4; ++r) *(LAS bf16_t*)(PL + (16 * w + 4 * kq) * 272 + 2 * cI + r * 272 + sb * 32) = f2bf(wf[sb][r] * invf[r] + wb[sb][r] * invb[r]);
    __syncthreads();
    float outv[2][8][4];
#pragma unroll
    for (int cb = 0; cb < 2; ++cb) {
        const int e = 32 * w + 16 * cb + cI;
        bf16x8 bv[4], bcf[8], bcb[8];
        { const bf16_t* vp = VT + (size_t)(h * ADH + e) * S_ + t0 + 8 * kq; const bf16_t* cf = CT + (size_t)(h * NCH + c) * 65536 + (size_t)e * 256 + 8 * kq; const bf16_t* cbp = CT + (size_t)((4 + h) * NCH + c) * 65536 + (size_t)e * 256 + 8 * kq;
#pragma unroll
          for (int k2 = 0; k2 < 4; ++k2) bv[k2] = *(const bf16x8*)(vp + 32 * k2);
#pragma unroll
          for (int ks = 0; ks < 8; ++ks) { bcf[ks] = *(const bf16x8*)(cf + 32 * ks); bcb[ks] = *(const bf16x8*)(cbp + 32 * ks); } }
#pragma unroll
        for (int rb = 0; rb < 8; ++rb) {
            f32x4 oP = (f32x4){0.f, 0.f, 0.f, 0.f}, oF = oP, oB = oP;
#pragma unroll
            for (int k2 = 0; k2 < 4; ++k2) { const bf16x8 pa = *(const LAS bf16x8*)(PL + rb * 4352 + ap[k2]); oP = __builtin_amdgcn_mfma_f32_16x16x32_bf16(pa, bv[k2], oP, 0, 0, 0); }
#pragma unroll
            for (int ks = 0; ks < 8; ++ks) { const bf16x8 qa = *(const LAS bf16x8*)(QL + rb * 8192 + aq[ks]);
                oF = __builtin_amdgcn_mfma_f32_16x16x32_bf16(qa, bcf[ks], oF, 0, 0, 0); oB = __builtin_amdgcn_mfma_f32_16x16x32_bf16(qa, bcb[ks], oB, 0, 0, 0); }
            const f32x4 af = *(const LAS f32x4*)(alfl + 16 * rb + 4 * kq), ab = *(const LAS f32x4*)(albl + 16 * rb + 4 * kq);
#pragma unroll
            for (int r = 0; r < 4; ++r) { const float o = oP[r] + af[r] * oF[r] + ab[r] * oB[r]; outv[cb][rb][r] = o; float q = o * o; q += __shfl_xor(q, 1); q += __shfl_xor(q, 2); q += __shfl_xor(q, 4); q += __shfl_xor(q, 8);
                if (cI == 0) sspl[(2 * w + cb) * 128 + 16 * rb + 4 * kq + r] = q; }
            __builtin_amdgcn_sched_barrier(0);
        }
    }
    __syncthreads();
    if (tid < 128) { float s = 0.f;
#pragma unroll
        for (int ww = 0; ww < 16; ++ww) s += sspl[ww * 128 + tid];
        rstdl[tid] = 1.0f / sqrtf(s * (1.f / 256.f) + NORM_EPS); }
    __syncthreads();
    const float* norm_g = F.in[6]; LAS float* OL = (LAS float*)F.lds;
#pragma unroll
    for (int cb = 0; cb < 2; ++cb) { const int col = 32 * w + 16 * cb + cI; const float g = norm_g[h * ADH + col];
#pragma unroll
        for (int rb = 0; rb < 8; ++rb) { const f32x4 rs = *(const LAS f32x4*)(rstdl + 16 * rb + 4 * kq);
#pragma unroll
            for (int r = 0; r < 4; ++r) OL[(16 * rb + 4 * kq + r) * 256 + col] = outv[cb][rb][r] * rs[r] * g; } }
    __syncthreads();
    const bf16_t* Z = (const bf16_t*)(F.ws + WS_Z); bf16_t* YA = (bf16_t*)(F.ws + WS_YA);
#pragma unroll 2
    for (int j = 0; j < 8; ++j) { const int p = tid + 512 * j, row = p >> 5, ch = p & 31;
        const f32x4 x0 = *(const LAS f32x4*)(OL + row * 256 + 8 * ch), x1 = *(const LAS f32x4*)(OL + row * 256 + 8 * ch + 4);
        const u32x4 so = *(const u32x4*)(Z + (size_t)(t0 + row) * ZW + ZC_OA + h * ADH + 8 * ch);
        u32x4 o; o.x = cvt_pk_bf16(x0.x * bf_lo(so.x), x0.y * bf_hi(so.x)); o.y = cvt_pk_bf16(x0.z * bf_lo(so.y), x0.w * bf_hi(so.y)); o.z = cvt_pk_bf16(x1.x * bf_lo(so.z), x1.y * bf_hi(so.z)); o.w = cvt_pk_bf16(x1.z * bf_lo(so.w), x1.w * bf_hi(so.w));
        *(u32x4*)(YA + (size_t)(t0 + row) * AW + h * ADH + 8 * ch) = o; }
    __syncthreads();
}
using pg8::Unit;
struct OrderPlain {
    const char* A; const char* B; size_t tstep; int nM, nN, G, c;
    __device__ __forceinline__ bool next(int i, Unit& u) const { u.aux = 0; return pg8::static_tile(i * G + c, nM, nN, u.pm, u.pn); }
    __device__ __forceinline__ const char* a_ptr(const Unit& u) const { return A + (size_t)u.pm * tstep; }
    __device__ __forceinline__ const char* b_ptr(const Unit& u) const { return B + (size_t)u.pn * tstep; }
};
struct OrderProj {
    const char *A0, *B0; long dA, dB; size_t tstep; int nM, nN, G, c;
    __device__ __forceinline__ bool next(int i, Unit& u) const { u.aux = i & 1; return pg8::static_tile((i >> 1) * G + c, nM, nN, u.pm, u.pn); }
    __device__ __forceinline__ const char* a_ptr(const Unit& u) const { return A0 + (long)u.aux * dA + (size_t)u.pm * tstep; }
    __device__ __forceinline__ const char* b_ptr(const Unit& u) const { return B0 + (long)u.aux * dB + (size_t)u.pn * tstep; }
};
struct OrderMoe {
    const char* A; const char* B; size_t tstep, estep; int nN, G, c; const LAS int* tile_e;
    __device__ __forceinline__ bool next(int i, Unit& u) const {
        const int nM = tile_e[255], nwg = nM * nN, L = i * G + c; if (L >= nwg) return false;
        int wgid = L; { const int q = nwg / 8, r = nwg % 8, xcd = wgid % 8, off = wgid / 8; wgid = (xcd < r ? xcd * (q + 1) : r * (q + 1) + (xcd - r) * q) + off; }
        u.pm = __builtin_amdgcn_readfirstlane(wgid / nN); u.pn = __builtin_amdgcn_readfirstlane(wgid % nN); u.aux = __builtin_amdgcn_readfirstlane(tile_e[u.pm]); return true; }
    __device__ __forceinline__ const char* a_ptr(const Unit& u) const { return A + (size_t)u.pm * tstep; }
    __device__ __forceinline__ const char* b_ptr(const Unit& u) const { return B + (size_t)u.aux * estep + (size_t)u.pn * tstep; }
};

struct NoPre {};
struct EpiZ {
    static constexpr bool PERM = true, CHAIN = false; typedef NoPre Pre;
    bf16_t* Z; float* GT;
    __device__ __forceinline__ void prefetch(Pre&, const Unit&, int, int, int, int) const {}
    __device__ __forceinline__ void operator()(const f32x4 (&acc)[2][2][4][2], const Unit& u, int wr, int wc, int fr, int fq, const Pre&) const {
        const int row0 = u.pm * 256 + wr * 64 + fr;
        if (u.pn == 38) {
            if (wc == 0 && fq < 2) {
#pragma unroll
                for (int ai = 0; ai < 2; ++ai)
#pragma unroll
                    for (int m = 0; m < 4; ++m) { float* gp = GT + (size_t)(row0 + ai * 128 + m * 16) * 16 + 8 * fq; *(f32x4*)gp = acc[ai][0][m][0]; *(f32x4*)(gp + 4) = acc[ai][0][m][1]; } }
            return; }
        const bool sg = (u.pn >= 12 && u.pn < 16) || (u.pn >= 22);
        const int col0 = u.pn * 256 + wc * 32 + 8 * fq;
#pragma unroll
        for (int ai = 0; ai < 2; ++ai)
#pragma unroll
            for (int m = 0; m < 4; ++m) { bf16_t* rowp = Z + (size_t)(row0 + ai * 128 + m * 16) * ZW + col0;
#pragma unroll
                for (int bj = 0; bj < 2; ++bj) { f32x4 v0 = acc[ai][bj][m][0], v1 = acc[ai][bj][m][1];
                    if (sg) {
#pragma unroll
                        for (int j = 0; j < 4; ++j) { v0[j] = sigmoidf_(v0[j]); v1[j] = sigmoidf_(v1[j]); } }
                    u32x4 w; w.x = cvt_pk_bf16(v0[0], v0[1]); w.y = cvt_pk_bf16(v0[2], v0[3]); w.z = cvt_pk_bf16(v1[0], v1[1]); w.w = cvt_pk_bf16(v1[2], v1[3]);
                    *(u32x4*)(rowp + bj * 128) = w; } }
    }
};
struct EpiProj {
    static constexpr bool PERM = true, CHAIN = true; typedef NoPre Pre;
    const bf16_t* Z; bf16_t* MIX;
    __device__ __forceinline__ void prefetch(Pre&, const Unit&, int, int, int, int) const {}
    __device__ __forceinline__ void mid(f32x4 (&acc)[2][2][4][2], const Unit& u, int wr, int wc, int fr, int fq) const {
        const int row0 = u.pm * 256 + wr * 64 + fr, col0 = u.pn * 256 + wc * 32 + 8 * fq;
#pragma unroll
        for (int ai = 0; ai < 2; ++ai)
#pragma unroll
            for (int m = 0; m < 4; ++m) { const size_t row = (size_t)(row0 + ai * 128 + m * 16);
#pragma unroll
                for (int bj = 0; bj < 2; ++bj) { const u32x4 ga = *(const u32x4*)(Z + row * ZW + ZC_GA + col0 + bj * 128), gb = *(const u32x4*)(Z + row * ZW + ZC_GB + col0 + bj * 128);
                    f32x4& v0 = acc[ai][bj][m][0]; f32x4& v1 = acc[ai][bj][m][1];
                    v0[0] *= bf_lo(ga.x) * __builtin_amdgcn_rcpf(bf_lo(gb.x)); v0[1] *= bf_hi(ga.x) * __builtin_amdgcn_rcpf(bf_hi(gb.x)); v0[2] *= bf_lo(ga.y) * __builtin_amdgcn_rcpf(bf_lo(gb.y)); v0[3] *= bf_hi(ga.y) * __builtin_amdgcn_rcpf(bf_hi(gb.y));
                    v1[0] *= bf_lo(ga.z) * __builtin_amdgcn_rcpf(bf_lo(gb.z)); v1[1] *= bf_hi(ga.z) * __builtin_amdgcn_rcpf(bf_hi(gb.z)); v1[2] *= bf_lo(ga.w) * __builtin_amdgcn_rcpf(bf_lo(gb.w)); v1[3] *= bf_hi(ga.w) * __builtin_amdgcn_rcpf(bf_hi(gb.w)); } }
    }
    __device__ __forceinline__ void operator()(const f32x4 (&acc)[2][2][4][2], const Unit& u, int wr, int wc, int fr, int fq, const Pre&) const {
        const int row0 = u.pm * 256 + wr * 64 + fr, col0 = u.pn * 256 + wc * 32 + 8 * fq;
#pragma unroll
        for (int ai = 0; ai < 2; ++ai)
#pragma unroll
            for (int m = 0; m < 4; ++m) { const size_t row = (size_t)(row0 + ai * 128 + m * 16);
#pragma unroll
                for (int bj = 0; bj < 2; ++bj) { const u32x4 g = *(const u32x4*)(Z + row * ZW + ZC_GB + col0 + bj * 128);
                    const f32x4 v0 = acc[ai][bj][m][0], v1 = acc[ai][bj][m][1];
                    u32x4 w; w.x = cvt_pk_bf16(v0[0] * bf_lo(g.x), v0[1] * bf_hi(g.x)); w.y = cvt_pk_bf16(v0[2] * bf_lo(g.y), v0[3] * bf_hi(g.y)); w.z = cvt_pk_bf16(v1[0] * bf_lo(g.z), v1[1] * bf_hi(g.z)); w.w = cvt_pk_bf16(v1[2] * bf_lo(g.w), v1[3] * bf_hi(g.w));
                    *(u32x4*)(MIX + row * DM + col0 + bj * 128) = w; } }
    }
};
struct EpiRes {
    static constexpr bool PERM = false, CHAIN = false; typedef NoPre Pre;
    const float* X; float* H;
    __device__ __forceinline__ void prefetch(Pre&, const Unit&, int, int, int, int) const {}
    __device__ __forceinline__ void operator()(const f32x4 (&acc)[2][2][4][2], const Unit& u, int wr, int wc, int fr, int fq, const Pre&) const {
        const int row0 = u.pm * 256 + wr * 64 + fr, col0 = u.pn * 256 + wc * 32 + 4 * fq;
#pragma unroll
        for (int ai = 0; ai < 2; ++ai)
#pragma unroll
            for (int m = 0; m < 4; ++m) { const size_t off = (size_t)(row0 + ai * 128 + m * 16) * DM + col0;
#pragma unroll
                for (int bj = 0; bj < 2; ++bj)
#pragma unroll
                    for (int n = 0; n < 2; ++n) *(f32x4*)(H + off + bj * 128 + n * 16) = *(const f32x4*)(X + off + bj * 128 + n * 16) + acc[ai][bj][m][n]; }
    }
};
struct EpiGlu {
    static constexpr bool PERM = true, CHAIN = false; struct Pre { f32x4 bg0, bg1, bu0, bu1; };
    const float* bias; unsigned char* ACT;
    __device__ __forceinline__ void prefetch(Pre& p, const Unit& u, int wr, int wc, int fr, int fq) const {
        const float* bp = bias + (size_t)u.aux * 4096 + u.pn * 128 + wc * 32 + 8 * fq; p.bg0 = *(const f32x4*)bp; p.bg1 = *(const f32x4*)(bp + 4); p.bu0 = *(const f32x4*)(bp + 2048); p.bu1 = *(const f32x4*)(bp + 2052); }
    __device__ __forceinline__ void operator()(const f32x4 (&acc)[2][2][4][2], const Unit& u, int wr, int wc, int fr, int fq, const Pre& p) const {
        const int row0 = u.pm * 256 + wr * 64 + fr, j0 = wc * 32 + 8 * fq, col0 = u.pn * 128 + j0;
        const f32x4 bg0 = p.bg0, bg1 = p.bg1, bu0 = p.bu0, bu1 = p.bu1;
#pragma unroll
        for (int ai = 0; ai < 2; ++ai)
#pragma unroll
            for (int m = 0; m < 4; ++m) { const size_t row = (size_t)(row0 + ai * 128 + m * 16);
                f32x4 o[2];
#pragma unroll
                for (int n = 0; n < 2; ++n) { const f32x4 gt = acc[ai][0][m][n] * W8_INV + (n ? bg1 : bg0), up = acc[ai][1][m][n] * W8_INV + (n ? bu1 : bu0);
#pragma unroll
                    for (int j = 0; j < 4; ++j) { const float g = fminf(gt[j], 7.0f), uu = fminf(fmaxf(up[j], -7.0f), 7.0f); o[n][j] = (uu + 1.0f) * g * sigmoidf_(g * 1.702f); } }
                u32x2 w; w.x = cvt4_fp8(o[0][0], o[0][1], o[0][2], o[0][3]); w.y = cvt4_fp8(o[1][0], o[1][1], o[1][2], o[1][3]);
                *(u32x2*)(ACT + row * DFF + col0) = w; }
    }
};
struct EpiDown {
    static constexpr bool PERM = true, CHAIN = false; typedef NoPre Pre;
    const float* bias; const int* rasg; const float* rw; bf16_t* YS;
    __device__ __forceinline__ void prefetch(Pre&, const Unit&, int, int, int, int) const {}
    __device__ __forceinline__ void operator()(const f32x4 (&acc)[2][2][4][2], const Unit& u, int wr, int wc, int fr, int fq, const Pre&) const {
        const int row0 = u.pm * 256 + wr * 64 + fr, col0 = u.pn * 256 + wc * 32 + 8 * fq;
        const float* bp = bias + (size_t)u.aux * DM + col0;
        int ra[8]; float rwv[8];
#pragma unroll
        for (int i = 0; i < 8; ++i) { const int row = row0 + (i >> 2) * 128 + (i & 3) * 16; ra[i] = rasg[row]; rwv[i] = rw[row]; }
        f32x4 bv[2][2];
#pragma unroll
        for (int bj = 0; bj < 2; ++bj) { bv[bj][0] = *(const f32x4*)(bp + bj * 128); bv[bj][1] = *(const f32x4*)(bp + bj * 128 + 4); }
#pragma unroll
        for (int ai = 0; ai < 2; ++ai)
#pragma unroll
            for (int m = 0; m < 4; ++m) { const int a = ra[ai * 4 + m]; const float wgt = rwv[ai * 4 + m];
                if (a >= 0) {
#pragma unroll
                    for (int bj = 0; bj < 2; ++bj) { const f32x4 v0 = (acc[ai][bj][m][0] * W8_INV + bv[bj][0]) * wgt, v1 = (acc[ai][bj][m][1] * W8_INV + bv[bj][1]) * wgt;
                        u32x4 w; w.x = cvt_pk_bf16(v0[0], v0[1]); w.y = cvt_pk_bf16(v0[2], v0[3]); w.z = cvt_pk_bf16(v1[0], v1[1]); w.w = cvt_pk_bf16(v1[2], v1[3]);
                        *(u32x4*)(YS + (size_t)a * DM + col0 + bj * 128) = w; } } }
    }
};
constexpr int R_TILE = 0, R_PART = 69632, R_SS = 102400, R_RSTD = 103424, R_LOG = 103680, R_HIST = 108032, R_SEL = 108544;
__device__ __forceinline__ void p7_router(Frame& F) {
    const int lane = F.lane, w = F.wave, tid = F.tid, r32 = lane & 31, hi = lane >> 5;
    const float* H1 = (const float*)(F.ws + WS_H1); const float* g = F.in[12]; const float* wrt = F.in[13]; const float* brt = F.in[14];
    unsigned char* U8 = F.ws + WS_U;
    int* TOPI = (int*)(F.ws + WS_TOPI); float* TOPW = (float*)(F.ws + WS_TOPW); int* SLOT = (int*)(F.ws + WS_SLOT); int* HIST = (int*)(F.ws + WS_SLOT + 512 * 1024);
    LAS float* tile = (LAS float*)(F.lds + R_TILE + w * 8320); LAS float* part = (LAS float*)(F.lds + R_PART); LAS float* ssp = (LAS float*)(F.lds + R_SS);
    LAS float* rstdl = (LAS float*)(F.lds + R_RSTD); LAS float* logl = (LAS float*)(F.lds + R_LOG); LAS int* hist = (LAS int*)(F.lds + R_HIST); LAS int* sel = (LAS int*)(F.lds + R_SEL);
    for (int tt = F.vcu; tt < S_ / 32; tt += F.G) {
        const int t0 = 32 * tt;
        if (tid < 64) hist[tid] = 0;
        f32x16 acc = {}; float ss = 0.f;
        for (int sub = 0; sub < 4; ++sub) {
            const int k0 = 256 * w + 64 * sub; const int rr = lane >> 4, cq = lane & 15;
            f32x4 hv[8]; float bw[32], gw_[32];
#pragma unroll
            for (int it = 0; it < 8; ++it) hv[it] = *(const f32x4*)(H1 + (size_t)(t0 + 4 * it + rr) * DM + k0 + 4 * cq);
#pragma unroll
            for (int kk = 0; kk < 32; ++kk) { const int k = k0 + 2 * kk + hi; bw[kk] = wrt[(size_t)k * NE + r32]; gw_[kk] = g[k]; }
#pragma unroll
            for (int it = 0; it < 8; ++it) { LAS float* tp = tile + (4 * it + rr) * 65 + 4 * cq; tp[0] = hv[it].x; tp[1] = hv[it].y; tp[2] = hv[it].z; tp[3] = hv[it].w; }
            LDS_WAIT(); asm volatile("" ::: "memory");
#pragma unroll
            for (int kk = 0; kk < 32; ++kk) { const float a = tile[r32 * 65 + 2 * kk + hi]; const float b = gw_[kk] * bw[kk];
                ss = fmaf(a, a, ss); acc = __builtin_amdgcn_mfma_f32_32x32x2f32(a, b, acc, 0, 0, 0); }
            LDS_WAIT(); asm volatile("" ::: "memory");
        }
        ss += __shfl_xor(ss, 32);
        if (hi == 0) ssp[w * 32 + r32] = ss;
#pragma unroll
        for (int r = 0; r < 16; ++r) part[(w * 32 + ((r & 3) + 8 * (r >> 2) + 4 * hi)) * 32 + r32] = acc[r];
        __syncthreads();
#pragma unroll
        for (int j = 0; j < 2; ++j) { const int idx = tid * 2 + j, t = idx >> 5, e = idx & 31; float s = 0.f, q = 0.f;
#pragma unroll
            for (int ww = 0; ww < 8; ++ww) { s += part[(ww * 32 + t) * 32 + e]; q += ssp[ww * 32 + t]; }
            const float rstd = 1.0f / sqrtf(q * (1.f / 2048.f) + NORM_EPS);
            logl[t * 33 + e] = s * rstd + brt[e]; if (e == 0) rstdl[t] = rstd; }
        __syncthreads();
        if (tid < 32) { const int t = tid; float v[4]; int ix[4]; unsigned used = 0u;
#pragma unroll
            for (int k = 0; k < 4; ++k) { float best = -3.0e38f; int bi = 0;
                for (int e = 0; e < NE; ++e) { const float x = logl[t * 33 + e]; if (!((used >> e) & 1u) && x > best) { best = x; bi = e; } }
                v[k] = best; ix[k] = bi; used |= 1u << bi; }
            const float e1 = __expf(v[1] - v[0]), e2 = __expf(v[2] - v[0]), e3 = __expf(v[3] - v[0]); const float inv = 1.0f / (1.0f + e1 + e2 + e3);
            const float wk[4] = {inv, e1 * inv, e2 * inv, e3 * inv};
#pragma unroll
            for (int k = 0; k < 4; ++k) { TOPI[(t0 + t) * 4 + k] = ix[k]; TOPW[(t0 + t) * 4 + k] = wk[k]; sel[t * 8 + k] = ix[k]; sel[t * 8 + 4 + k] = atomicAdd((int*)&hist[ix[k]], 1); } }
        __syncthreads();
        if (tid < 32) { HIST[tt * 32 + tid] = hist[tid];
#pragma unroll
            for (int k = 0; k < 4; ++k) SLOT[(t0 + tid) * 4 + k] = sel[tid * 8 + 4 + k]; }
#pragma unroll
        for (int rr = 0; rr < 4; ++rr) { const int row = 4 * w + rr; const float rstd = rstdl[row]; const float* xr = H1 + (size_t)(t0 + row) * DM; unsigned char* orow = U8 + (size_t)(t0 + row) * DM;
#pragma unroll
            for (int j = 0; j < 8; ++j) { const f32x4 v = *(const f32x4*)(xr + 256 * j + 4 * lane); const f32x4 gg = *(const f32x4*)(g + 256 * j + 4 * lane);
                *(unsigned*)(orow + 256 * j + 4 * lane) = cvt4_fp8(v.x * rstd * gg.x, v.y * rstd * gg.y, v.z * rstd * gg.z, v.w * rstd * gg.w); } }
        __syncthreads();
    }
}

__device__ __forceinline__ void moe_tables(Frame& F) {
    LAS int* ps = (LAS int*)(F.lds + MISC_OFF + 256); LAS int* te = (LAS int*)(F.lds + TILE_E_OFF);
    if (F.tid == 0) { int cum = 0;
        for (int e = 0; e < NE; ++e) { const int n = (int)__hip_atomic_load(F.ctl + CW_CNT + e, RLX_AGENT); const int nt = (n + 255) >> 8; ps[e] = cum * 256; for (int j = 0; j < nt && cum < 255; ++j) te[cum++] = e; }
        te[255] = cum; }
    __syncthreads();
}
__device__ __forceinline__ void p8_scatter(Frame& F) {
    const int lane = F.lane, tid = F.tid;
    const int* TOPI = (const int*)(F.ws + WS_TOPI); const float* TOPW = (const float*)(F.ws + WS_TOPW); const int* SLOT = (const int*)(F.ws + WS_SLOT); const int* HIST = (const int*)(F.ws + WS_SLOT + 512 * 1024);
    int* rasg = (int*)(F.ws + WS_RASG); float* rw = (float*)(F.ws + WS_RW);
    const unsigned char* U8 = F.ws + WS_U; unsigned char* XG = F.ws + WS_XG;
    LAS int* part = (LAS int*)(F.lds);
    LAS int* rowb = (LAS int*)(F.lds + 4096);
    for (int tt = F.vcu; tt < S_ / 32; tt += F.G) {
        { const int jg = tid >> 5, e = tid & 31; int lt = 0, al = 0;
#pragma unroll
          for (int j = 0; j < 16; ++j) { const int jj = jg * 16 + j; const int v = HIST[jj * 32 + e]; al += v; lt += (jj < tt) ? v : 0; }
          part[(jg * 32 + e) * 2] = lt; part[(jg * 32 + e) * 2 + 1] = al; }
        __syncthreads();
        if (tid < 32) { int lt = 0, al = 0;
#pragma unroll
            for (int jg = 0; jg < 16; ++jg) { lt += part[(jg * 32 + tid) * 2]; al += part[(jg * 32 + tid) * 2 + 1]; }
            const int nt = (al + 255) >> 8; int sc = nt;
#pragma unroll
            for (int o = 1; o < 32; o <<= 1) { const int v = __shfl_up(sc, o); if (tid >= o) sc += v; }
            rowb[tid] = (sc - nt) * 256 + lt;
            if (tt == 0) __hip_atomic_store(F.ctl + CW_CNT + tid, (unsigned)al, RLX_AGENT); }
        __syncthreads();
        { const int a0 = tt * 128 + 16 * F.wave; int rr = 0;
          if (lane < 16) { const int a = a0 + lane; const int e = TOPI[a]; rr = rowb[e] + SLOT[a]; rasg[rr] = a; rw[rr] = TOPW[a]; }
#pragma unroll
          for (int q = 0; q < 4; ++q) { u32x4 v[4][2]; int r[4];
#pragma unroll
              for (int j = 0; j < 4; ++j) { const int i = 4 * q + j, t = (a0 + i) >> 2; r[j] = __shfl(rr, i); const u32x4* src = (const u32x4*)(U8 + (size_t)t * DM); v[j][0] = src[lane]; v[j][1] = src[64 + lane]; }
#pragma unroll
              for (int j = 0; j < 4; ++j) { u32x4* dst = (u32x4*)(XG + (size_t)r[j] * DM); dst[lane] = v[j][0]; dst[64 + lane] = v[j][1]; } } }
        __syncthreads();
    }
}
__device__ __forceinline__ void p11_final(Frame& F) {
    const int gw = F.vcu * NWAVES + F.wave, NGW = F.G * NWAVES, lane = F.lane;
    const float* H1 = (const float*)(F.ws + WS_H1); const bf16_t* YS = (const bf16_t*)(F.ws + WS_YS); const float* g = F.in[19];
    for (int t = gw; t < S_; t += NGW) {
        f32x4 v[8]; float s = 0.f;
#pragma unroll
        for (int j = 0; j < 8; ++j) { v[j] = __builtin_nontemporal_load((const f32x4*)(H1 + (size_t)t * DM + 256 * j + 4 * lane));
#pragma unroll
            for (int k = 0; k < 4; ++k) { const u32x2 y = __builtin_nontemporal_load((const u32x2*)(YS + (size_t)(4 * t + k) * DM + 256 * j + 4 * lane)); v[j].x += bf_lo(y.x); v[j].y += bf_hi(y.x); v[j].z += bf_lo(y.y); v[j].w += bf_hi(y.y); }
            s += (v[j].x * v[j].x + v[j].y * v[j].y) + (v[j].z * v[j].z + v[j].w * v[j].w); }
        const float rstd = 1.0f / sqrtf(wave_sum(s) * (1.f / 2048.f) + NORM_EPS);
#pragma unroll
        for (int j = 0; j < 8; ++j) { const f32x4 gg = *(const f32x4*)(g + 256 * j + 4 * lane); __builtin_nontemporal_store(v[j] * rstd * gg, (f32x4*)(F.out + (size_t)t * DM + 256 * j + 4 * lane)); }
    }
}

__device__ __forceinline__ void ph1(Frame& F) {
    unsigned char* ws = F.ws;
    if (is_converter(F)) { p1_convert(F); return; }
    const bool split = (F.G == 256);
    const int Gg = split ? 8 * (32 - CONV_PER_XCD) : F.G, cg = split ? ((F.vcu & 31) * 8 + (F.vcu >> 5)) : (int)blockIdx.x;
    OrderPlain S{(const char*)(ws + WS_U), (const char*)(ws + WS_WIN), (size_t)256 * DM * 2, S_ / 256, NIN / 256, Gg, cg};
    EpiZ E{(bf16_t*)(ws + WS_Z), (float*)(ws + WS_GATES)};
    pg8::gemm_phase<EpiZ, OrderPlain>(F.lds, DM * 2, S, E);
}
__device__ __forceinline__ void ph2(Frame& F) { p2a_mlstm_prep(F); p2b_attn_prep(F); p2c_gate_prep(F); }
__device__ __forceinline__ void ph4a(Frame& F, char* lds) {
    unsigned char* ws = F.ws;
    for (int u = F.vcu; u < BH * (S_ / 256); u += F.G) { const int head = u >> 5, qb = u & 31;
        attn::attn_dense_body((const bf16_t*)(ws + WS_QB) + (size_t)qb * 256 * BW + head * BDH, (const bf16_t*)(ws + WS_KB) + (head >> 2) * BDH, (const bf16_t*)(ws + WS_VB) + (head >> 2) * BDH,
                              (bf16_t*)(ws + WS_YB) + (size_t)qb * 256 * BW + head * BDH, S_, lds);
        __syncthreads(); }
}
__device__ __forceinline__ void ph4b(Frame& F) {
    if (F.vcu < AH * NCH) mlstm_out_unit(F, F.vcu >> 6, F.vcu & 63);
    __syncthreads();
}
__device__ __forceinline__ void ph5(Frame& F) {
    unsigned char* ws = F.ws;
    OrderProj S{(const char*)(ws + WS_YA), (const char*)(ws + WS_WPA), (long)(WS_YB - WS_YA), (long)(WS_WPB - WS_WPA), (size_t)256 * AW * 2, S_ / 256, DM / 256, F.G, (int)blockIdx.x};
    EpiProj E{(const bf16_t*)(ws + WS_Z), (bf16_t*)(ws + WS_MIX)};
    pg8::gemm_phase<EpiProj, OrderProj>(F.lds, AW * 2, S, E);
}
__device__ __forceinline__ void ph6(Frame& F) {
    unsigned char* ws = F.ws;
    OrderPlain S{(const char*)(ws + WS_MIX), (const char*)(ws + WS_WOUT), (size_t)256 * DM * 2, S_ / 256, DM / 256, F.G, (int)blockIdx.x};
    EpiRes E{F.in[0], (float*)(ws + WS_H1)};
    pg8::gemm_phase<EpiRes, OrderPlain>(F.lds, DM * 2, S, E);
}
__device__ __forceinline__ void ph9(Frame& F) {
    unsigned char* ws = F.ws;
    moe_tables(F);
    OrderMoe S{(const char*)(ws + WS_XG), (const char*)(ws + WS_WGU), (size_t)256 * DM, (size_t)4096 * DM, 16, F.G, (int)blockIdx.x, (const LAS int*)(F.lds + TILE_E_OFF)};
    EpiGlu E{F.in[16], ws + WS_ACT};
    pg8::gemm_phase<EpiGlu, OrderMoe, true>(F.lds, DM, S, E);
}
__device__ __forceinline__ void ph10(Frame& F) {
    unsigned char* ws = F.ws;
    moe_tables(F);
    OrderMoe S{(const char*)(ws + WS_ACT), (const char*)(ws + WS_WDN), (size_t)256 * DFF, (size_t)DM * DFF, 8, F.G, (int)blockIdx.x, (const LAS int*)(F.lds + TILE_E_OFF)};
    EpiDown E{F.in[18], (const int*)(ws + WS_RASG), (const float*)(ws + WS_RW), (bf16_t*)(ws + WS_YS)};
    pg8::gemm_phase<EpiDown, OrderMoe, true>(F.lds, DFF, S, E);
}

constexpr int N_PHASES = 12;
struct Args { const float* in[20]; float* out; unsigned char* ws; int ph_lo, ph_hi; };
__global__ void __launch_bounds__(NTHR, 2) fwd_kernel(Args args) {
    extern __shared__ __attribute__((aligned(16))) unsigned char lds[];
    Frame F;
    F.lds = (LAS unsigned char*)lds; F.ws = args.ws; F.ctl = (gu32*)(args.ws + WS_CTL);
    F.tid = threadIdx.x; F.lane = F.tid & 63; F.wave = __builtin_amdgcn_readfirstlane(F.tid >> 6);
    F.G = gridDim.x; { const int bx = blockIdx.x; F.vcu = (F.G % 8 == 0) ? (bx % 8) * (F.G / 8) + bx / 8 : bx; }
#pragma unroll
    for (int i = 0; i < 20; ++i) F.in[i] = args.in[i];
    F.out = args.out;
    volatile LAS unsigned* MISC = (volatile LAS unsigned*)(F.lds + MISC_OFF);
    if (F.tid < 64) MISC[F.tid] = 0u;
    __syncthreads();
    const int lo = args.ph_lo, hi = args.ph_hi;
    XcdBarrier bar; bar.bar = (unsigned*)(F.ctl + CW_BAR); bar.x = 0; bar.st = nullptr;
    if (hi - lo > 1) bar = xcd_barrier_post((unsigned*)(F.ctl + CW_BAR), MISC + 8);
#ifndef PHASE_MASK
#define PHASE_MASK 0xFFF
#endif
#define IN(k) (((PHASE_MASK >> (k)) & 1) && lo <= (k) && (k) < hi)
#ifndef PROBE_DUP
#define PROBE_DUP 0
#endif
#define DUP(k) ((PROBE_DUP >> (k)) & 1)
#define SEAM(k) do { if (IN(k) && IN((k) + 1)) xcd_barrier(bar); } while (0)

    if (IN(0)) { p0_prologue(F); if (DUP(0)) { __syncthreads(); p0_prologue(F); } } SEAM(0);
    if (IN(1)) { ph1(F); if (DUP(1)) ph1(F); } SEAM(1);
    if (IN(2)) { ph2(F); if (DUP(2)) ph2(F); } SEAM(2);
    if (IN(3)) { p3_state_scan(F); if (DUP(3)) p3_state_scan(F); } SEAM(3);
    if (IN(4)) {
#ifndef NO_ATT
        for (int rep_ = 0; rep_ < 1 + DUP(12); ++rep_) ph4a(F, (char*)lds);
#else
        { u32x4* yb = (u32x4*)(F.ws + WS_YB); for (int i = (F.vcu * NWAVES + F.wave) * 64 + F.lane; i < S_ * BW / 8; i += F.G * NTHR) yb[i] = (u32x4){0u, 0u, 0u, 0u}; }
#endif
#ifndef NO_ML
        ph4b(F); if (DUP(13)) ph4b(F);
#endif
    } SEAM(4);
    if (IN(5)) { ph5(F); if (DUP(5)) ph5(F); } SEAM(5);
    if (IN(6)) { ph6(F); if (DUP(6)) ph6(F); } SEAM(6);
    if (IN(7)) { p7_router(F); if (DUP(7)) p7_router(F); } SEAM(7);
    if (IN(8)) { p8_scatter(F); if (DUP(8)) p8_scatter(F); } SEAM(8);
    if (IN(9)) { ph9(F); if (DUP(9)) ph9(F); } SEAM(9);
    if (IN(10)) { ph10(F); if (DUP(10)) ph10(F); } SEAM(10);
    if (IN(11)) { p11_final(F); if (DUP(11)) p11_final(F); }
    if (DUP(14)) { for (int i_ = 0; i_ < 20; ++i_) xcd_barrier(bar); }
#undef IN
#undef SEAM
}

extern "C" void kernel_launch(void* const* d_in, const int* in_sizes, int n_in, void* d_out, int out_size, void* d_ws, size_t ws_size, hipStream_t stream) {
    static int grid = 0;
    if (grid == 0) {
        if (n_in != 20 || in_sizes[0] != S_ * DM || out_size != S_ * DM || ws_size < WS_END) { fprintf(stderr, "kernel_launch: unexpected shapes (n_in %d, in0 %d, out %d, ws %zu < %zu)\n", n_in, n_in > 0 ? in_sizes[0] : -1, out_size, ws_size, (size_t)WS_END); grid = -1; return; }
        int dev = 0, cus = 0, per_cu = 0;
        if (hipGetDevice(&dev) != hipSuccess || hipDeviceGetAttribute(&cus, hipDeviceAttributeMultiprocessorCount, dev) != hipSuccess) { grid = -1; return; }
        if (hipFuncSetAttribute((const void*)fwd_kernel, hipFuncAttributeMaxDynamicSharedMemorySize, LDS_BYTES) != hipSuccess) { fprintf(stderr, "kernel_launch: hipFuncSetAttribute failed\n"); grid = -1; return; }
        if (hipOccupancyMaxActiveBlocksPerMultiprocessor(&per_cu, (const void*)fwd_kernel, NTHR, LDS_BYTES) != hipSuccess || per_cu < 1) fprintf(stderr, "kernel_launch: note: occupancy query reports %d\n", per_cu);
        (void)hipGetLastError();
        grid = cus;
        if (grid != 256) { fprintf(stderr, "kernel_launch: built for the 256-CU MI355X (one workgroup per CU); found %d CUs\n", cus); grid = -1; return; }
    }
    if (grid < 0) return;
    if (hipMemsetAsync((char*)d_ws + WS_CTL, 0, CTL_ZERO_BYTES, stream) != hipSuccess) return;
    Args a{};
    for (int i = 0; i < 20; ++i) a.in[i] = (const float*)d_in[i];
    a.out = (float*)d_out; a.ws = (unsigned char*)d_ws;
#ifndef MK_PER_PHASE
#define MK_PER_PHASE 0
#endif
#if MK_PER_PHASE
    for (int p = 0; p < N_PHASES; ++p) { a.ph_lo = p; a.ph_hi = p + 1; hipLaunchKernelGGL(fwd_kernel, dim3(grid), dim3(NTHR), LDS_BYTES, stream, a); }
#else
    a.ph_lo = 0; a.ph_hi = N_PHASES; hipLaunchKernelGGL(fwd_kernel, dim3(grid), dim3(NTHR), LDS_BYTES, stream, a);
#endif
    const hipError_t le = hipPeekAtLastError();
    if (le != hipSuccess) fprintf(stderr, "kernel_launch: launch failed: %s\n", hipGetErrorName(le));
}
```

```cpp
#include <hip/hip_runtime.h>
#include <hip/hip_bf16.h>
#include <cstdio>
#include <cstdint>

#define GAS __attribute__((address_space(1)))
#define LAS __attribute__((address_space(3)))
typedef unsigned short bf16_t;
typedef short bf16x8 __attribute__((ext_vector_type(8)));
typedef short s16x4 __attribute__((ext_vector_type(4)));
typedef float f32x4 __attribute__((ext_vector_type(4)));
typedef float f32x2 __attribute__((ext_vector_type(2)));
typedef float f32x16 __attribute__((ext_vector_type(16)));
typedef unsigned u32x4 __attribute__((ext_vector_type(4)));
typedef unsigned u32x2 __attribute__((ext_vector_type(2)));
typedef int i32x8 __attribute__((ext_vector_type(8)));

__device__ __forceinline__ unsigned cvt_pk_bf16(float lo, float hi) { unsigned r; asm volatile("v_cvt_pk_bf16_f32 %0, %1, %2" : "=v"(r) : "v"(lo), "v"(hi)); return r; }
__device__ __forceinline__ float bf_lo(unsigned w) { return __uint_as_float(w << 16); }
__device__ __forceinline__ float bf_hi(unsigned w) { return __uint_as_float(w & 0xffff0000u); }
__device__ __forceinline__ float bf2f(bf16_t b) { return __uint_as_float(((unsigned)b) << 16); }
__device__ __forceinline__ bf16_t f2bf(float f) { return (bf16_t)(cvt_pk_bf16(f, 0.f) & 0xffffu); }
__device__ __forceinline__ unsigned cvt4_fp8(float a, float b, float c, float d) { int p = __builtin_amdgcn_cvt_pk_fp8_f32(a, b, 0, false); p = __builtin_amdgcn_cvt_pk_fp8_f32(c, d, p, true); return (unsigned)p; }
__device__ __forceinline__ float sigmoidf_(float x) { return __builtin_amdgcn_rcpf(1.0f + __builtin_amdgcn_exp2f(-1.4426950408889634f * x)); }

__device__ __forceinline__ void mfma_fp8_16x16x128(f32x4& acc, const i32x8& a, const i32x8& b, int unit_scale) {
    (void)unit_scale; asm volatile("v_mfma_f32_16x16x128_f8f6f4 %0, %1, %2, %0" : "+v"(acc) : "v"(a), "v"(b));
}
namespace pg8 {
constexpr int BM = 256, BK = 64, HALF = 128, HTB = HALF * BK * 2  , STAGE_BYTES = 8 * HTB, NXCD = 8, WGM = 8;
__host__ __device__ __forceinline__ int lds_byte(int r, int c) { const int st = (r >> 4) * 2 + (c >> 5), rr = r & 15, cc = c & 31, ob = rr * 64 + cc * 2; return st * 1024 + (ob ^ (((ob >> 9) & 1) << 5)); }
__host__ __device__ __forceinline__ void stage_rc(int b, int& R, int& C) { const int st = b / 1024, sb = b % 1024, swz = sb ^ (((sb >> 9) & 1) << 5); R = (st >> 1) * 16 + swz / 64; C = (st & 1) * 32 + (swz % 64) / 2; }
__host__ __device__ __forceinline__ int perm32(int rho) { const int n = rho >> 4, i = rho & 15; return 8 * (i >> 2) + 4 * n + (i & 3); }

struct Unit { int pm, pn, aux; };

__device__ __forceinline__ bool static_tile(int L, int nM, int nN, int& pm, int& pn) {
    const int nwg = nM * nN; if (L >= nwg) return false;
    int wgid = L; { const int q = nwg / NXCD, r = nwg % NXCD, xcd = wgid % NXCD, off = wgid / NXCD; wgid = (xcd < r ? xcd * (q + 1) : r * (q + 1) + (xcd - r) * q) + off; }
    const int nig = WGM * nN, gid = wgid / nig, fm = gid * WGM, gsz = (nM - fm) < WGM ? (nM - fm) : WGM;
    pm = fm + ((wgid % nig) % gsz); pn = (wgid % nig) / gsz; return true;
}

template <class Epi, class Sched, bool FP8 = false>
__device__ __forceinline__ void gemm_phase(LAS unsigned char* lds, const int KB, const Sched& S, const Epi& E) {
    const int tid = threadIdx.x, wid = __builtin_amdgcn_readfirstlane(tid >> 6), lane = tid & 63, wr = wid >> 2, wc = wid & 3, fr = lane & 15, fq = lane >> 4;
    const int nt = KB / 128;
    unsigned voffA[2], voffB[2];
#pragma unroll
    for (int i = 0; i < 2; ++i) { int R, C; stage_rc(tid * 16 + i * 8192, R, C); const int Rb = Epi::PERM ? ((R & ~31) + perm32(R & 31)) : R;
        voffA[i] = (unsigned)(R * KB + C * 2); voffB[i] = (unsigned)(Rb * KB + C * 2); }
    const size_t kstep = (size_t)(BK * 2);
    const size_t hstep = (size_t)HALF * KB;
    const unsigned ldsw = (unsigned)wid * 1024u;
    const int aoff = lds_byte(wr * 64 + fr, fq * 8), boff = lds_byte(wc * 32 + fr, fq * 8);
#define PG8_SA(b, h) (((b) * 2 + (h)) * HTB)
#define PG8_SB(b, h) ((4 + (b) * 2 + (h)) * HTB)
#define PG8_STAGE(bufoff, gbase, voff) do { _Pragma("unroll") for (int _i = 0; _i < 2; ++_i) \
        __builtin_amdgcn_global_load_lds((const unsigned*)((const char*)(gbase) + (voff)[_i]), (LAS unsigned*)(lds + (bufoff) + ldsw + _i * 8192), 16, 0, 0); } while (0)
#define PG8_LDA(dst, b, h) do { if constexpr (FP8) { _Pragma("unroll") for (int m = 0; m < 4; ++m) { const u32x4 lo_ = *(const LAS u32x4*)(lds + PG8_SA(b, h) + aoff + m * 2048), hi_ = *(const LAS u32x4*)(lds + PG8_SA(b, h) + aoff + m * 2048 + 1024); \
            dst##8[m] = (i32x8){(int)lo_.x, (int)lo_.y, (int)lo_.z, (int)lo_.w, (int)hi_.x, (int)hi_.y, (int)hi_.z, (int)hi_.w}; } } \
        else { _Pragma("unroll") for (int m = 0; m < 4; ++m) _Pragma("unroll") for (int k = 0; k < 2; ++k) dst[m][k] = *(const LAS bf16x8*)(lds + PG8_SA(b, h) + aoff + m * 2048 + k * 1024); } } while (0)
#define PG8_LDB(dst, b, h) do { if constexpr (FP8) { _Pragma("unroll") for (int n = 0; n < 2; ++n) { const u32x4 lo_ = *(const LAS u32x4*)(lds + PG8_SB(b, h) + boff + n * 2048), hi_ = *(const LAS u32x4*)(lds + PG8_SB(b, h) + boff + n * 2048 + 1024); \
            dst##8[n] = (i32x8){(int)lo_.x, (int)lo_.y, (int)lo_.z, (int)lo_.w, (int)hi_.x, (int)hi_.y, (int)hi_.z, (int)hi_.w}; } } \
        else { _Pragma("unroll") for (int n = 0; n < 2; ++n) _Pragma("unroll") for (int k = 0; k < 2; ++k) dst[n][k] = *(const LAS bf16x8*)(lds + PG8_SB(b, h) + boff + n * 2048 + k * 1024); } } while (0)
#define PG8_MMA(ai, bj, At, Bt) do { __builtin_amdgcn_s_setprio(1); if constexpr (FP8) { _Pragma("unroll") for (int m = 0; m < 4; ++m) _Pragma("unroll") for (int n = 0; n < 2; ++n) \
            mfma_fp8_16x16x128(acc[ai][bj][m][n], Bt##8[n], At##8[m], unit_scale); } \
        else { _Pragma("unroll") for (int m = 0; m < 4; ++m) _Pragma("unroll") for (int n = 0; n < 2; ++n) _Pragma("unroll") for (int k = 0; k < 2; ++k) \
            acc[ai][bj][m][n] = __builtin_amdgcn_mfma_f32_16x16x32_bf16(Bt[n][k], At[m][k], acc[ai][bj][m][n], 0, 0, 0); } __builtin_amdgcn_s_setprio(0); } while (0)
#define PG8_WAIT_V(n) asm volatile("s_waitcnt vmcnt(" #n ")" ::: "memory")
#define PG8_WAIT_L(n) asm volatile("s_waitcnt lgkmcnt(" #n ")" ::: "memory")
#define PG8_BAR __builtin_amdgcn_s_barrier()
#define PG8_SCHED __builtin_amdgcn_sched_barrier(0)
    Unit cur, nxt; int ui = 0; const int unit_scale = 0x7F7F7F7F;
    if (!S.next(0, cur)) return;
    f32x4 acc[2][2][4][2];
#pragma unroll
    for (int a = 0; a < 2; ++a)
#pragma unroll
        for (int b = 0; b < 2; ++b)
#pragma unroll
            for (int m = 0; m < 4; ++m)
#pragma unroll
                for (int n = 0; n < 2; ++n) acc[a][b][m][n] = (f32x4){0.f, 0.f, 0.f, 0.f};
    typename Epi::Pre pre;
    bf16x8 At[4][2], B0[2][2], B1[2][2]; i32x8 At8[4], B08[2], B18[2];
    const char* cA = S.a_ptr(cur); const char* cB = S.b_ptr(cur);
    PG8_STAGE(PG8_SB(0, 0), cB, voffB); PG8_STAGE(PG8_SB(0, 1), cB + hstep, voffB); PG8_STAGE(PG8_SA(0, 0), cA, voffA); PG8_STAGE(PG8_SA(0, 1), cA + hstep, voffA);
    if (wr == 1) PG8_BAR;
    PG8_WAIT_V(2); PG8_BAR;
    PG8_STAGE(PG8_SB(1, 0), cB + kstep, voffB); PG8_STAGE(PG8_SA(1, 0), cA + kstep, voffA); PG8_STAGE(PG8_SB(1, 1), cB + hstep + kstep, voffB);
    PG8_WAIT_V(6); PG8_BAR;
    for (;;) {
        const bool has_next = S.next(ui + 1, nxt);
        const char* nA = has_next ? S.a_ptr(nxt) : cA; const char* nB = has_next ? S.b_ptr(nxt) : cB;
        for (int t = 0; t < nt; t += 2) {
            const bool last = (t == nt - 2);
            const char* a1 = cA + (size_t)(t + 1) * kstep;
            const char* a2 = last ? nA : cA + (size_t)(t + 2) * kstep; const char* b2 = last ? nB : cB + (size_t)(t + 2) * kstep;
            const char* a3 = a2 + kstep; const char* b3 = b2 + kstep;
            if (last) E.prefetch(pre, cur, wr, wc, fr, fq);
            PG8_LDB(B0, 0, 0); PG8_LDB(B1, 0, 1); PG8_SCHED; PG8_LDA(At, 0, 0); PG8_STAGE(PG8_SA(1, 1), a1 + hstep, voffA);
            PG8_WAIT_V(8); PG8_WAIT_L(0); PG8_BAR; PG8_MMA(0, 0, At, B0); PG8_MMA(0, 1, At, B1); PG8_BAR; PG8_SCHED;
            PG8_LDA(At, 0, 1); PG8_STAGE(PG8_SB(0, 0), b2, voffB); PG8_STAGE(PG8_SB(0, 1), b2 + hstep, voffB); PG8_STAGE(PG8_SA(0, 0), a2, voffA);
            PG8_WAIT_V(8); PG8_WAIT_L(0); PG8_BAR; PG8_MMA(1, 0, At, B0); PG8_MMA(1, 1, At, B1); PG8_BAR; PG8_SCHED;
            PG8_LDB(B0, 1, 0); PG8_LDB(B1, 1, 1); PG8_SCHED; PG8_LDA(At, 1, 0); PG8_STAGE(PG8_SA(0, 1), a2 + hstep, voffA);
            PG8_WAIT_V(8); PG8_WAIT_L(0); PG8_BAR; PG8_MMA(0, 0, At, B0); PG8_MMA(0, 1, At, B1); PG8_BAR; PG8_SCHED;
            PG8_LDA(At, 1, 1); PG8_STAGE(PG8_SB(1, 0), b3, voffB); PG8_STAGE(PG8_SB(1, 1), b3 + hstep, voffB); PG8_STAGE(PG8_SA(1, 0), a3, voffA);
            PG8_WAIT_V(8); PG8_WAIT_L(0); PG8_BAR; PG8_MMA(1, 0, At, B0); PG8_MMA(1, 1, At, B1); PG8_BAR; PG8_SCHED;
        }
        if (wr == 0) PG8_BAR;
        if constexpr (FP8) asm volatile("s_nop 15\n\ts_nop 15" ::: "memory");
        bool keep = false;
        if constexpr (Epi::CHAIN) { keep = (cur.aux == 0); if (keep) E.mid(acc, cur, wr, wc, fr, fq); else E(acc, cur, wr, wc, fr, fq, pre); }
        else E(acc, cur, wr, wc, fr, fq, pre);
        if (!has_next) break;
        if (!keep) {
#pragma unroll
        for (int a = 0; a < 2; ++a)
#pragma unroll
            for (int b = 0; b < 2; ++b)
#pragma unroll
                for (int m = 0; m < 4; ++m)
#pragma unroll
                    for (int n = 0; n < 2; ++n) acc[a][b][m][n] = (f32x4){0.f, 0.f, 0.f, 0.f};
        }
        cur = nxt; cA = nA; cB = nB; ++ui;
        if (wr == 1) PG8_BAR;
    }
    PG8_WAIT_V(0);
    PG8_BAR;
#undef PG8_SA
#undef PG8_SB
#undef PG8_STAGE
#undef PG8_LDA
#undef PG8_LDB
#undef PG8_MMA
#undef PG8_WAIT_V
#undef PG8_WAIT_L
#undef PG8_BAR
#undef PG8_SCHED
}
}
namespace attn {
constexpr int D = 128, NW = 8, QBLK = 32, KVBLK = 64;
constexpr float SCALE = 0.088388347648318440f;
constexpr float THR = 8.f;
constexpr int LDQ = 1024, LDK = 256, LDO = 1024;
constexpr size_t SHM_V = KVBLK * D * 2, SHM_K = KVBLK * D * 2, SHM_ATTN = 2 * SHM_V + 2 * SHM_K + NW * 64 * 4;
#define KSWZ(row, colB) ((row) * 256 + ((colB) ^ (((row) & 7) << 4)))
#define SBAR() __builtin_amdgcn_sched_barrier(0)
#define CBAR() asm volatile("" ::: "memory")
#define ABAR() do { asm volatile("s_waitcnt lgkmcnt(0)" ::: "memory"); __builtin_amdgcn_s_barrier(); asm volatile("" ::: "memory"); } while (0)
__device__ __forceinline__ int crow(int r, int hi) { return (r & 3) + 8 * (r >> 2) + 4 * hi; }
__device__ __forceinline__ unsigned cvtpk(float lo, float hi) { unsigned r; asm volatile("v_cvt_pk_bf16_f32 %0, %1, %2" : "=v"(r) : "v"(lo), "v"(hi)); return r; }

__device__ __forceinline__ void partialSM(f32x16& p0, f32x16& p1, float& m_reg, float& mn, float& alpha) {
  constexpr float C = SCALE * 1.4426950408889634f;
  float pmax = p0[0];
#pragma unroll
  for (int r = 1; r < 16; ++r) pmax = fmaxf(pmax, p0[r]);
#pragma unroll
  for (int r = 0; r < 16; ++r) pmax = fmaxf(pmax, p1[r]);
  { auto rr = __builtin_amdgcn_permlane32_swap(__float_as_uint(pmax), __float_as_uint(pmax), false, false);
    pmax = fmaxf(__uint_as_float(rr[0]), __uint_as_float(rr[1])); }
  if (__builtin_expect(__all(pmax - m_reg <= THR / SCALE), 1)) { mn = m_reg; alpha = 1.f; }
  else { mn = fmaxf(m_reg, pmax); alpha = __builtin_amdgcn_exp2f((m_reg - mn) * C); m_reg = mn; }
  float mnC = -mn * C;
#pragma unroll
  for (int r = 0; r < 16; ++r) p0[r] = fmaf(p0[r], C, mnC);
#pragma unroll
  for (int r = 0; r < 16; ++r) p1[r] = fmaf(p1[r], C, mnC);
#pragma unroll
  for (int r = 0; r < 16; ++r) p0[r] = __builtin_amdgcn_exp2f(p0[r]);
}
__device__ __forceinline__ void finishSM(f32x16& p0, f32x16& p1, float alpha, float& l_reg, bf16x8& pa0, bf16x8& pa1, bf16x8& pa2, bf16x8& pa3) {
#pragma unroll
  for (int r = 0; r < 16; ++r) p1[r] = __builtin_amdgcn_exp2f(p1[r]);
  float ps = 0;
#pragma unroll
  for (int r = 0; r < 16; ++r) ps += p0[r];
#pragma unroll
  for (int r = 0; r < 16; ++r) ps += p1[r];
  { auto rr = __builtin_amdgcn_permlane32_swap(__float_as_uint(ps), __float_as_uint(ps), false, false);
    ps = __uint_as_float(rr[0]) + __uint_as_float(rr[1]); }
  l_reg = l_reg * alpha + ps;
#define PK4(P, BASE, OUT) do { unsigned a0 = cvtpk(P[BASE + 0], P[BASE + 1]), a1 = cvtpk(P[BASE + 2], P[BASE + 3]);   \
    unsigned b0 = cvtpk(P[BASE + 4], P[BASE + 5]), b1 = cvtpk(P[BASE + 6], P[BASE + 7]);                              \
    auto r0 = __builtin_amdgcn_permlane32_swap(a0, b0, false, false); auto r1 = __builtin_amdgcn_permlane32_swap(a1, b1, false, false); \
    u32x4 w = {r0[0], r1[0], r0[1], r1[1]}; OUT = *reinterpret_cast<bf16x8*>(&w); } while (0)
  PK4(p0, 0, pa0); PK4(p0, 8, pa1); PK4(p1, 0, pa2); PK4(p1, 8, pa3);
#undef PK4
}
__device__ __forceinline__ void qkt(f32x16& p0, f32x16& p1, const bf16_t* Ks, const bf16x8* qr, int r32, int hi) {
  p0 = f32x16{}; p1 = f32x16{};
#pragma unroll
  for (int d0 = 0; d0 < 8; ++d0) { int cb = (d0 * 16 + hi * 8) * 2;
    bf16x8 b0 = *reinterpret_cast<const bf16x8*>((const char*)Ks + KSWZ(r32, cb));
    bf16x8 b1 = *reinterpret_cast<const bf16x8*>((const char*)Ks + KSWZ(32 + r32, cb));
    p0 = __builtin_amdgcn_mfma_f32_32x32x16_bf16(b0, qr[d0], p0, 0, 0, 0);
    p1 = __builtin_amdgcn_mfma_f32_32x32x16_bf16(b1, qr[d0], p1, 0, 0, 0); }
}
__device__ __forceinline__ int v_st(int k, int c) { const int kk = (k & ~0xC) | ((k & 4) << 1) | ((k & 8) >> 1); return ((kk >> 3) * 4 + (c >> 5)) * 512 + ((kk & 7) * 32 + (c & 31)) * 2; }
__device__ __forceinline__ int v_rd_base(int lane) { return ((lane & 3) << 3) | (((lane >> 2) & 3) << 6) | (((lane >> 4) & 1) << 5) | (((lane >> 5) & 1) << 8); }
constexpr int v_rd_off(int d0, int ks, int half) { return d0 * 512 + ks * 4096 + half * 2048; }
template <int OFF> __device__ __forceinline__ s16x4 tr_read(int vb) {
  s16x4 r; asm volatile("ds_read_b64_tr_b16 %0, %1 offset:%2" : "=&v"(r) : "v"(vb), "i"(OFF) : "memory"); return r;
}
template <int D0> __device__ __forceinline__ void pv_one(f32x16& od, int vb, bf16x8 pa0, bf16x8 pa1, bf16x8 pa2, bf16x8 pa3) {
  const s16x4 l0 = tr_read<v_rd_off(D0, 0, 0)>(vb), h0 = tr_read<v_rd_off(D0, 0, 1)>(vb), l1 = tr_read<v_rd_off(D0, 1, 0)>(vb), h1 = tr_read<v_rd_off(D0, 1, 1)>(vb);
  const s16x4 l2 = tr_read<v_rd_off(D0, 2, 0)>(vb), h2 = tr_read<v_rd_off(D0, 2, 1)>(vb), l3 = tr_read<v_rd_off(D0, 3, 0)>(vb), h3 = tr_read<v_rd_off(D0, 3, 1)>(vb);
  asm volatile("s_waitcnt lgkmcnt(0)" ::: "memory"); SBAR();
#define PK(L, H) (bf16x8){L[0], L[1], L[2], L[3], H[0], H[1], H[2], H[3]}
  od = __builtin_amdgcn_mfma_f32_32x32x16_bf16(pa0, PK(l0, h0), od, 0, 0, 0);
  od = __builtin_amdgcn_mfma_f32_32x32x16_bf16(pa1, PK(l1, h1), od, 0, 0, 0);
  od = __builtin_amdgcn_mfma_f32_32x32x16_bf16(pa2, PK(l2, h2), od, 0, 0, 0);
  od = __builtin_amdgcn_mfma_f32_32x32x16_bf16(pa3, PK(l3, h3), od, 0, 0, 0);
#undef PK
}
__device__ __forceinline__ void pv_d0(f32x16* o, int vb, bf16x8 pa0, bf16x8 pa1, bf16x8 pa2, bf16x8 pa3) {
  pv_one<0>(o[0], vb, pa0, pa1, pa2, pa3); pv_one<1>(o[1], vb, pa0, pa1, pa2, pa3); pv_one<2>(o[2], vb, pa0, pa1, pa2, pa3); pv_one<3>(o[3], vb, pa0, pa1, pa2, pa3);
}

template <class FillT>
__device__ __forceinline__ void attn_dense_body(const bf16_t* __restrict__ Qb, const bf16_t* __restrict__ Kh, const bf16_t* __restrict__ Vh, bf16_t* __restrict__ Ob, int seq, char* lds, const FillT& fl) {
  const int tid = threadIdx.x, wid = tid >> 6, lane = tid & 63, r32 = lane & 31, hi = lane >> 5;
  bf16_t* V_lds = (bf16_t*)lds; bf16_t* K_lds = (bf16_t*)(lds + 2 * SHM_V);
  float* ws = (float*)(lds + 2 * SHM_V + 2 * SHM_K) + wid * 64; float* li_l = ws; float* al_l = ws + 32;
  float m_reg = -1e30f, l_reg = 0; f32x16 o[4] = {}; bf16x8 qr[8];
  const bf16_t* Qw = Qb + (long)(wid * QBLK + r32) * LDQ + hi * 8;
#pragma unroll
  for (int d0 = 0; d0 < 8; ++d0) qr[d0] = *reinterpret_cast<const bf16x8*>(Qw + d0 * 16);
  const int sr = tid >> 4, sc = (tid & 15) * 8, vst0 = v_st(sr, sc), vst1 = v_st(32 + sr, sc);
  const int vb0 = (int)(uintptr_t)V_lds + v_rd_base(lane);
  struct { bf16x8 vs0, vs1, ks0, ks1; } sr_[1];
#define SLOAD(i, k0) do { sr_[i].vs0 = *reinterpret_cast<const bf16x8*>(&Vh[(long)((k0) + sr) * LDK + sc]); sr_[i].vs1 = *reinterpret_cast<const bf16x8*>(&Vh[(long)((k0) + 32 + sr) * LDK + sc]); \
    sr_[i].ks0 = *reinterpret_cast<const bf16x8*>(&Kh[(long)((k0) + sr) * LDK + sc]); sr_[i].ks1 = *reinterpret_cast<const bf16x8*>(&Kh[(long)((k0) + 32 + sr) * LDK + sc]); } while (0)
#define SWRITE(b, i) do { *(bf16x8*)((char*)V_lds + (b) * SHM_V + vst0) = sr_[i].vs0;          \
    *(bf16x8*)((char*)V_lds + (b) * SHM_V + vst1) = sr_[i].vs1; int kc = sc * 2;               \
    *(bf16x8*)((char*)K_lds + (b) * SHM_K + KSWZ(sr, kc)) = sr_[i].ks0;                       \
    *(bf16x8*)((char*)K_lds + (b) * SHM_K + KSWZ(32 + sr, kc)) = sr_[i].ks1; } while (0)
#define RESC(a) do { if (__any((a) < 1.f)) { if (hi == 0) al_l[r32] = (a); asm volatile("s_waitcnt lgkmcnt(0)" ::: "memory"); \
    _Pragma("unroll") for (int d = 0; d < 4; ++d) _Pragma("unroll") for (int r = 0; r < 16; ++r) o[d][r] *= al_l[crow(r, hi)]; } } while (0)
  f32x16 pA0, pA1, pB0, pB1; float mnA, mnB, alA, alB; bf16x8 pa0, pa1, pa2, pa3; const int NT = seq / KVBLK;
  SLOAD(0, 0); SWRITE(0, 0); ABAR();
  qkt(pA0, pA1, K_lds, qr, r32, hi); partialSM(pA0, pA1, m_reg, mnA, alA);
  SLOAD(0, KVBLK); SWRITE(1, 0); CBAR();
  int fs = 0; SBAR(); fl.issue(0); SBAR();
  SLOAD(0, 2 * KVBLK);
  ABAR();
  for (int j = 1; j + 1 < NT; j += 2) {
    SBAR(); qkt(pB0, pB1, (bf16_t*)((char*)K_lds + SHM_K), qr, r32, hi);
    finishSM(pA0, pA1, alA, l_reg, pa0, pa1, pa2, pa3); SBAR();
    fl.consume(fs); ++fs; SBAR();
    pv_d0(o, vb0, pa0, pa1, pa2, pa3); partialSM(pB0, pB1, m_reg, mnB, alB);
    ABAR(); SWRITE(0, 0); CBAR(); SLOAD(0, (j + 2) * KVBLK); SBAR(); fl.issue(fs); SBAR();
    RESC(alB); ABAR();
    SBAR(); qkt(pA0, pA1, K_lds, qr, r32, hi);
    finishSM(pB0, pB1, alB, l_reg, pa0, pa1, pa2, pa3); SBAR();
    pv_d0(o, vb0 + (int)SHM_V, pa0, pa1, pa2, pa3); partialSM(pA0, pA1, m_reg, mnA, alA);
    ABAR(); SWRITE(1, 0); CBAR(); SLOAD(0, (j + 3 < NT ? j + 3 : NT - 1) * KVBLK);
    RESC(alA); ABAR();
  }
  fl.consume(fs);
  SBAR(); qkt(pB0, pB1, (bf16_t*)((char*)K_lds + SHM_K), qr, r32, hi);
  finishSM(pA0, pA1, alA, l_reg, pa0, pa1, pa2, pa3); SBAR();
  pv_d0(o, vb0, pa0, pa1, pa2, pa3); partialSM(pB0, pB1, m_reg, mnB, alB);
  ABAR(); RESC(alB);
  finishSM(pB0, pB1, alB, l_reg, pa0, pa1, pa2, pa3); SBAR();
  pv_d0(o, vb0 + (int)SHM_V, pa0, pa1, pa2, pa3);
  if (hi == 0) li_l[r32] = l_reg; asm volatile("s_waitcnt lgkmcnt(0)" ::: "memory");
  float rli[16];
#pragma unroll
  for (int r = 0; r < 16; ++r) rli[r] = __builtin_amdgcn_rcpf(li_l[crow(r, hi)]);
  bf16_t* Ow = Ob + (long)(wid * QBLK) * LDO;
#pragma unroll
  for (int r = 0; r < 16; ++r) { int orow = crow(r, hi);
#pragma unroll
    for (int d0 = 0; d0 < 4; ++d0) Ow[(long)orow * LDO + d0 * 32 + r32] = f2bf(o[d0][r] * rli[r]); }
#undef SLOAD
#undef SWRITE
#undef RESC
}
#undef KSWZ
#undef SBAR
#undef ABAR
#undef CBAR
}
constexpr int NWAVES = 8, NTHR = 512;
constexpr int S_ = 8192, DM = 2048;
constexpr int AH = 4, ADH = 256, AW = 1024, ACH = 128, NCH = S_ / ACH;
constexpr int BH = 8, BKV = 2, BDH = 128, BW = 1024, BKW = 256;
constexpr int NE = 32, TOPK = 4, DFF = 2048;
constexpr int D_IN = 9744;
constexpr int ZW = 9728;
constexpr int NIN = 9984;
constexpr int ZC_QA = 0, ZC_KA = 1024, ZC_VA = 2048, ZC_OA = 3072, ZC_QB = 4096, ZC_KB = 5120, ZC_VB = 5376, ZC_GA = 5632, ZC_GB = 7680;
constexpr int PMAX = 40960;
constexpr float NORM_EPS = 1e-6f;
constexpr float W8_SCALE = 128.0f, W8_INV = 1.0f / 128.0f;

constexpr size_t MiB = 1u << 20;
constexpr size_t WS_CTL = 0, CTL_ZERO_BYTES = 1 * MiB;
constexpr size_t WS_WIN = 1 * MiB;
constexpr size_t WS_WPA = WS_WIN + 40 * MiB;
constexpr size_t WS_WPB = WS_WPA + 4 * MiB;
constexpr size_t WS_WOUT = WS_WPB + 4 * MiB;
constexpr size_t WS_WGU = WS_WOUT + 8 * MiB;
constexpr size_t WS_WDN = WS_WGU + 512 * MiB;
constexpr size_t WS_U = WS_WDN + 256 * MiB;
constexpr size_t WS_Z = WS_U + 32 * MiB;
constexpr size_t WS_GATES = WS_Z + 152 * MiB;
constexpr size_t WS_QM = WS_GATES + 1 * MiB;
constexpr size_t WS_KM = WS_QM + 16 * MiB;
constexpr size_t WS_KT = WS_KM + 16 * MiB;
constexpr size_t WS_VT = WS_KT + 16 * MiB;
constexpr size_t WS_QB = WS_VT + 16 * MiB;
constexpr size_t WS_KB = WS_QB + 16 * MiB;
constexpr size_t WS_VB = WS_KB + 4 * MiB;
constexpr size_t WS_GA = WS_VB + 4 * MiB;
constexpr size_t WS_GBV = WS_GA + 1 * MiB;
constexpr size_t WS_GCM = WS_GBV + 1 * MiB;
constexpr size_t WS_CHK = WS_GCM + 1 * MiB;
constexpr size_t WS_CT = WS_CHK + 1 * MiB;
constexpr size_t WS_NS = WS_CT + 64 * MiB;
constexpr size_t WS_YA = WS_NS + 1 * MiB;
constexpr size_t WS_YB = WS_YA + 16 * MiB;
constexpr size_t WS_T = WS_YB + 16 * MiB;
constexpr size_t WS_MIX = WS_T + 64 * MiB;
constexpr size_t WS_H1 = WS_MIX + 32 * MiB;
constexpr size_t WS_TOPI = WS_H1 + 64 * MiB;
constexpr size_t WS_TOPW = WS_TOPI + 1 * MiB;
constexpr size_t WS_SLOT = WS_TOPW + 1 * MiB;
constexpr size_t WS_RASG = WS_SLOT + 1 * MiB;
constexpr size_t WS_RW = WS_RASG + 1 * MiB;
constexpr size_t WS_XG = WS_RW + 1 * MiB;
constexpr size_t WS_ACT = WS_XG + 160 * MiB;
constexpr size_t WS_YS = WS_ACT + 160 * MiB;
constexpr size_t WS_END = WS_YS + 128 * MiB;
constexpr int CW_TMO = 0, CW_CODE = 1;
constexpr int CW_BAR = 4096;
constexpr int CW_CNT = 8192;
constexpr int RING_BYTES = 131072;
constexpr int MISC_OFF = RING_BYTES;
constexpr int TILE_E_OFF = RING_BYTES + 1024;
constexpr int LDS_BYTES = 147456;

typedef GAS unsigned gu32;
#define RLX_AGENT __ATOMIC_RELAXED, __HIP_MEMORY_SCOPE_AGENT
#define LDS_WAIT() asm volatile("s_waitcnt lgkmcnt(0)" ::: "memory")
#define VM_WAIT() asm volatile("s_waitcnt vmcnt(0)" ::: "memory")

#define XB_TMO      128
#define XB_XCNT(j)  (256  + 64 * (j))
#define XB_XSUB(j)  (1280 + 64 * (j))
#define XB_XGEN(j)  (2304 + 64 * (j))
#define XB_TOP      3328
#define XB_TOPGEN   3392
#define XCD_BAR_WORDS 3456
#define XB_SPIN_CAP (1u << 18)

__device__ __forceinline__ unsigned xb_ld(unsigned* p)              { return __hip_atomic_load(p, __ATOMIC_RELAXED, __HIP_MEMORY_SCOPE_AGENT); }
__device__ __forceinline__ unsigned xb_add(unsigned* p, unsigned v) { return __hip_atomic_fetch_add(p, v, __ATOMIC_RELAXED, __HIP_MEMORY_SCOPE_AGENT); }
__device__ __forceinline__ unsigned xb_xcc_id() { return (unsigned)__builtin_amdgcn_s_getreg((3 << 11) | 20) & 0xFu; }
#define XB_SPIN(cond, bar) do { unsigned _sp = 0; while (cond) { __builtin_amdgcn_s_sleep(1); \
    if ((++_sp & 255u) == 0u) { if (xb_ld(&(bar)[XB_TMO])) break; if (_sp > XB_SPIN_CAP) { atomicAdd(&(bar)[XB_TMO], 1u); break; } } } } while (0)

struct XcdBarrier {
    unsigned* bar; unsigned x;
    volatile LAS unsigned* st;
};
__device__ __forceinline__ XcdBarrier xcd_barrier_post(unsigned* bar, volatile LAS unsigned* st) {
    XcdBarrier b; b.bar = bar; b.x = xb_xcc_id(); b.st = st;
    if (threadIdx.x == 0) (void)xb_add(&bar[XB_XCNT(b.x)], 1u);
    return b;
}
__device__ __forceinline__ void xcd_barrier_complete(unsigned* bar, unsigned x, unsigned& nloc, unsigned& nx) {
    const unsigned G = gridDim.x * gridDim.y * gridDim.z;
    unsigned sum, cnt, mine, sp = 0u;
    for (;;) {
        sum = 0u; cnt = 0u; mine = 0u;
#pragma unroll
        for (unsigned j = 0; j < 16; ++j) { const unsigned c = xb_ld(&bar[XB_XCNT(j)]); sum += c; cnt += (c > 0u) ? 1u : 0u; mine = (j == x) ? c : mine; }
        if (sum == G) break;
        __builtin_amdgcn_s_sleep(1);
        if ((++sp & 255u) == 0u) { if (xb_ld(&bar[XB_TMO])) break; if (sp > XB_SPIN_CAP) { atomicAdd(&bar[XB_TMO], 1u); break; } }
    }
    nloc = mine > 0u ? mine : 1u; nx = cnt > 0u ? cnt : 1u;
}
__device__ __forceinline__ void xcd_barrier(const XcdBarrier& b) {
    asm volatile("s_waitcnt vmcnt(0)" ::: "memory");
    __syncthreads();
    if (threadIdx.x == 0) {
        unsigned* bar = b.bar;
        __builtin_amdgcn_s_waitcnt(0);
        unsigned nloc = b.st[0], nx = b.st[1];
        if (nloc == 0u) { xcd_barrier_complete(bar, b.x, nloc, nx); b.st[0] = nloc; b.st[1] = nx; }
        const unsigned old = xb_add(&bar[XB_XSUB(b.x)], 1u);
        const unsigned gen = old / nloc;
        if (old + 1u == (gen + 1u) * nloc) {
            __builtin_amdgcn_fence(__ATOMIC_RELEASE, "agent");
            asm volatile("s_waitcnt vmcnt(0)" ::: "memory");
            const unsigned og = xb_add(&bar[XB_TOP], 1u);
            const unsigned tg = og / nx;
            if (og + 1u == (tg + 1u) * nx) xb_add(&bar[XB_TOPGEN], 1u);
            else XB_SPIN(xb_ld(&bar[XB_TOPGEN]) == tg, bar);
            __builtin_amdgcn_fence(__ATOMIC_ACQUIRE, "agent");
            xb_add(&bar[XB_XGEN(b.x)], 1u);
            asm volatile("s_waitcnt vmcnt(0)" ::: "memory");
        } else {
            XB_SPIN(xb_ld(&bar[XB_XGEN(b.x)]) == gen, bar);
            __builtin_amdgcn_fence(__ATOMIC_ACQUIRE, "agent");
            asm volatile("s_waitcnt vmcnt(0)" ::: "memory");
        }
    }
    __syncthreads();
}

__device__ __forceinline__ float wave_sum(float v) {
#pragma unroll
    for (int o = 1; o < 64; o <<= 1) v += __shfl_xor(v, o);
    return v;
}
__device__ __forceinline__ float wave_max(float v) {
#pragma unroll
    for (int o = 1; o < 64; o <<= 1) v = fmaxf(v, __shfl_xor(v, o));
    return v;
}

struct Frame {
    LAS unsigned char* lds;
    unsigned char* ws;
    gu32* ctl;
    int tid, lane, wave, G, vcu;
    const float* in[20];
    float* out;
};
__device__ __forceinline__ void transpose_item(const float* __restrict__ W, int ldw, int k0, int c0, int valid, bf16_t* __restrict__ WT, int ldt, int r0, LAS unsigned char* scr, int lane) {
    const int kg = lane >> 4, ng = lane & 15;
    const bool ok = 4 * ng < valid;
#pragma unroll
    for (int it = 0; it < 4; ++it) {
        f32x4 v[4];
#pragma unroll
        for (int j = 0; j < 4; ++j) { const int k = k0 + 16 * it + 4 * kg + j; v[j] = ok ? __builtin_nontemporal_load((const f32x4*)(W + (size_t)k * ldw + c0 + 4 * ng)) : (f32x4){0.f, 0.f, 0.f, 0.f}; }
#pragma unroll
        for (int i = 0; i < 4; ++i) { u32x2 p; p.x = cvt_pk_bf16(v[0][i], v[1][i]); p.y = cvt_pk_bf16(v[2][i], v[3][i]);
            *(LAS u32x2*)(scr + (4 * ng + i) * 144 + (16 * it + 4 * kg) * 2) = p; }
    }
    LDS_WAIT(); asm volatile("" ::: "memory");
    const int c = lane & 7;
#pragma unroll
    for (int j2 = 0; j2 < 8; ++j2) { const int n = (lane >> 3) + 8 * j2; const u32x4 o = *(const LAS u32x4*)(scr + n * 144 + c * 16);
        *(u32x4*)(WT + (size_t)(r0 + n) * ldt + k0 + 8 * c) = o; }
    LDS_WAIT(); asm volatile("" ::: "memory");
}

__device__ __forceinline__ void transpose_item8(const float* __restrict__ W, int ldw, int k0, int c0, unsigned char* __restrict__ WT, int ldt, int r0, LAS unsigned char* scr, int lane) {
    const int kg = lane >> 4, ng = lane & 15;
#pragma unroll
    for (int it = 0; it < 8; ++it) {
        f32x4 v[4];
#pragma unroll
        for (int j = 0; j < 4; ++j) { const int k = k0 + 16 * it + 4 * kg + j; v[j] = __builtin_nontemporal_load((const f32x4*)(W + (size_t)k * ldw + c0 + 4 * ng)) * W8_SCALE; }
#pragma unroll
        for (int i = 0; i < 4; ++i) *(LAS unsigned*)(scr + (4 * ng + i) * 144 + (16 * it + 4 * kg)) = cvt4_fp8(v[0][i], v[1][i], v[2][i], v[3][i]);
    }
    LDS_WAIT(); asm volatile("" ::: "memory");
    const int c = lane & 7;
#pragma unroll
    for (int j2 = 0; j2 < 8; ++j2) { const int n = (lane >> 3) + 8 * j2; const u32x4 o = *(const LAS u32x4*)(scr + n * 144 + c * 16);
        __builtin_nontemporal_store(o, (u32x4*)(WT + (size_t)(r0 + n) * ldt + k0 + 16 * c)); }
    LDS_WAIT(); asm volatile("" ::: "memory");
}

struct Item8 { const float* W; unsigned char* WT; int ldw, ldt, k0, c0, r0; };
__device__ __forceinline__ Item8 moe_item8(Frame& F, int r) {
    Item8 t;
    if (r < NE * 64 * 16) { const int e = r / (64 * 16), q = r % (64 * 16), rb = q % 64, kb = q / 64, r0 = 64 * rb, pn = r0 >> 8, rem = r0 & 255, bj = rem >> 7, j0 = rem & 127;
        t.W = F.in[15] + (size_t)e * DM * 4096; t.ldw = 4096; t.k0 = 128 * kb; t.c0 = bj * 2048 + 128 * pn + j0; t.WT = F.ws + WS_WGU + (size_t)e * 4096 * DM; t.ldt = DM; t.r0 = r0; }
    else { r -= NE * 64 * 16; const int e = r / (32 * 16), q = r % (32 * 16), rb = q % 32, kb = q / 32;
        t.W = F.in[17] + (size_t)e * DFF * DM; t.ldw = DM; t.k0 = 128 * kb; t.c0 = 64 * rb; t.WT = F.ws + WS_WDN + (size_t)e * DM * DFF; t.ldt = DFF; t.r0 = 64 * rb; }
    return t;
}
#define HALF8_LOAD(V, T, hf) do { const int kg_ = lane >> 4, ng_ = lane & 15; _Pragma("unroll") for (int it = 0; it < 4; ++it) _Pragma("unroll") for (int j = 0; j < 4; ++j) \
        V[4 * it + j] = *(const f32x4*)((T).W + (size_t)((T).k0 + 64 * (hf) + 16 * it + 4 * kg_ + j) * (T).ldw + (T).c0 + 4 * ng_); } while (0)
#define HALF8_STORE(V, T, hf) do { const int kg_ = lane >> 4, ng_ = lane & 15; _Pragma("unroll") for (int it = 0; it < 4; ++it) _Pragma("unroll") for (int i = 0; i < 4; ++i) \
        *(LAS unsigned*)(scr + (4 * ng_ + i) * 80 + (16 * it + 4 * kg_)) = cvt4_fp8(V[4 * it][i] * W8_SCALE, V[4 * it + 1][i] * W8_SCALE, V[4 * it + 2][i] * W8_SCALE, V[4 * it + 3][i] * W8_SCALE); \
        LDS_WAIT(); asm volatile("" ::: "memory"); const int c_ = lane & 3; \
        _Pragma("unroll") for (int j2 = 0; j2 < 4; ++j2) { const int n = (lane >> 2) + 16 * j2; const u32x4 o = *(const LAS u32x4*)(scr + n * 80 + c_ * 16); \
            *(u32x4*)((T).WT + (size_t)((T).r0 + n) * (T).ldt + (T).k0 + 64 * (hf) + 16 * c_) = o; } \
        LDS_WAIT(); asm volatile("" ::: "memory"); } while (0)

__device__ __forceinline__ void rms_row_to_bf16(const float* __restrict__ xrow, const float* __restrict__ g, bf16_t* __restrict__ orow, int lane) {
    f32x4 v[8]; float s = 0.f;
#pragma unroll
    for (int j = 0; j < 8; ++j) { v[j] = *(const f32x4*)(xrow + 256 * j + 4 * lane); s += (v[j].x * v[j].x + v[j].y * v[j].y) + (v[j].z * v[j].z + v[j].w * v[j].w); }
    const float rstd = 1.0f / sqrtf(wave_sum(s) * (1.f / 2048.f) + NORM_EPS);
#pragma unroll
    for (int j = 0; j < 8; ++j) { const f32x4 gg = *(const f32x4*)(g + 256 * j + 4 * lane); u32x2 w; w.x = cvt_pk_bf16(v[j].x * rstd * gg.x, v[j].y * rstd * gg.y); w.y = cvt_pk_bf16(v[j].z * rstd * gg.z, v[j].w * rstd * gg.w);
        *(u32x2*)(orow + 256 * j + 4 * lane) = w; }
}

constexpr int I_IN = (NIN / 64) * 32, I_GU = NE * 64 * 16, I_DN = NE * 32 * 16, I_PA = 32 * 16, I_OUT = 32 * 32;
constexpr int NITEMS = I_IN + I_GU + I_DN + 2 * I_PA + I_OUT;
#ifndef X_ITEMS
#define X_ITEMS 32768
#endif
constexpr int A_ITEMS = 2048 * 8;
constexpr int CONV_PER_XCD = 12;
__device__ __forceinline__ bool is_converter(const Frame& F) { return F.G == 256 && (F.vcu & 31) >= 32 - CONV_PER_XCD; }
__device__ __forceinline__ void conv_item(Frame& F, int it, LAS unsigned char* scr) {
    const float* w_in = F.in[2]; const float* w_pa = F.in[9]; const float* w_pb = F.in[10]; const float* w_out = F.in[11]; const float* w_gu = F.in[15]; const float* w_dn = F.in[17];
    bf16_t* WIN = (bf16_t*)(F.ws + WS_WIN); bf16_t* WPA = (bf16_t*)(F.ws + WS_WPA); bf16_t* WPB = (bf16_t*)(F.ws + WS_WPB); bf16_t* WOUT = (bf16_t*)(F.ws + WS_WOUT);
    unsigned char* WGU = F.ws + WS_WGU; unsigned char* WDN = F.ws + WS_WDN;
    int r = it;
    if (r < I_IN) { const int rb = r / 32, kb = r % 32, r0 = 64 * rb; int c0, valid;
        if (r0 < 4096) { c0 = r0; valid = 64; } else if (r0 < ZW) { c0 = r0 + 16; valid = 64; } else if (r0 == ZW) { c0 = 4096; valid = 16; } else { c0 = 0; valid = 0; }
        transpose_item(w_in, D_IN, 64 * kb, c0, valid, WIN, DM, r0, scr, F.lane); return; }
    r -= I_IN;
    if (r < I_GU) { const int e = r / (64 * 16), q = r % (64 * 16), rb = q % 64, kb = q / 64, r0 = 64 * rb, pn = r0 >> 8, rem = r0 & 255, bj = rem >> 7, j0 = rem & 127;
        transpose_item8(w_gu + (size_t)e * DM * 4096, 4096, 128 * kb, bj * 2048 + 128 * pn + j0, WGU + (size_t)e * 4096 * DM, DM, r0, scr, F.lane); return; }
    r -= I_GU;
    if (r < I_DN) { const int e = r / (32 * 16), q = r % (32 * 16), rb = q % 32, kb = q / 32;
        transpose_item8(w_dn + (size_t)e * DFF * DM, DM, 128 * kb, 64 * rb, WDN + (size_t)e * DM * DFF, DFF, 64 * rb, scr, F.lane); return; }
    r -= I_DN;
    if (r < I_PA) { const int rb = r / 16, kb = r % 16; transpose_item(w_pa, DM, 64 * kb, 64 * rb, 64, WPA, AW, 64 * rb, scr, F.lane); return; }
    r -= I_PA;
    if (r < I_PA) { const int rb = r / 16, kb = r % 16; transpose_item(w_pb, DM, 64 * kb, 64 * rb, 64, WPB, BW, 64 * rb, scr, F.lane); return; }
    r -= I_PA;
    { const int rb = r / 32, kb = r % 32; transpose_item(w_out, DM, 64 * kb, 64 * rb, 64, WOUT, DM, 64 * rb, scr, F.lane); }
}
__device__ __forceinline__ void p0_prologue(Frame& F) {
    LAS unsigned char* scr = F.lds + F.wave * 9216;
    const int gw = F.vcu * NWAVES + F.wave, NGW = F.G * NWAVES;
    const int xi = (F.G == 256) ? A_ITEMS + X_ITEMS : 0;
    for (int j = gw; j < NITEMS - xi; j += NGW) conv_item(F, j < I_IN ? j : j + xi, scr);
    bf16_t* U = (bf16_t*)(F.ws + WS_U);
    for (int m = gw; m < S_; m += NGW) rms_row_to_bf16(F.in[0] + (size_t)m * DM, F.in[1], U + (size_t)m * DM, F.lane);
    int* rasg = (int*)(F.ws + WS_RASG); float* rw = (float*)(F.ws + WS_RW);
    for (int i = gw * 64 + F.lane; i < PMAX; i += NGW * 64) { rasg[i] = -1; rw[i] = 0.f; }
}
__device__ __forceinline__ void p1_convert(Frame& F) {
    LAS unsigned char* scr = F.lds + F.wave * 9216;
    const int cr = (F.vcu >> 5) * CONV_PER_XCD + ((F.vcu & 31) - (32 - CONV_PER_XCD));
    for (int j = cr * NWAVES + F.wave; j < X_ITEMS; j += 8 * CONV_PER_XCD * NWAVES) conv_item(F, I_IN + A_ITEMS + j, scr);
}

struct AttnFill {
    const float* w; unsigned char* o; LAS unsigned char* raw; LAS unsigned char* scr; int item0, lane;
    __device__ __forceinline__ void issue(int s) const {
        int ln = lane; asm volatile("" : "+v"(ln));
        const int kg = ln >> 3, ng = ln & 7;
        const int f = s >> 2, it = s & 3, r = item0 + (f >> 1), h = f & 1;
        const int e = r >> 10, q = r & 1023, rb = q & 63, kb = q >> 6, r0 = 64 * rb, c0 = ((r0 >> 7) & 1) * 2048 + 128 * (r0 >> 8) + (r0 & 127) + 32 * h;
        const float* src = w + (size_t)e * DM * 4096 + (size_t)(128 * kb + 32 * it) * 4096 + c0;
        const unsigned floff = (unsigned)(4 * kg * 4096 + 4 * ng);
#pragma unroll
        for (int j = 0; j < 4; ++j) __builtin_amdgcn_global_load_lds((const unsigned*)(src + (size_t)j * 4096 + floff), (LAS unsigned*)(raw + j * 1024), 16, 0, 2);
    }
    __device__ __forceinline__ void consume(int s) const {
        int ln = lane; asm volatile("" : "+v"(ln));
        const int kg = ln >> 3, ng = ln & 7;
        const int f = s >> 2, it = s & 3;
        asm volatile("s_waitcnt vmcnt(4)" ::: "memory");
        f32x4 fv[4];
#pragma unroll
        for (int j = 0; j < 4; ++j) fv[j] = *(const LAS f32x4*)(raw + j * 1024 + ln * 16);
        LAS unsigned char* wp = scr + (4 * ng) * 144 + 4 * kg + 32 * it;
#pragma unroll
        for (int i = 0; i < 4; ++i) *(LAS unsigned*)(wp + i * 144) = cvt4_fp8(fv[0][i] * W8_SCALE, fv[1][i] * W8_SCALE, fv[2][i] * W8_SCALE, fv[3][i] * W8_SCALE);
        if (it == 3) {
            const int r = item0 + (f >> 1), h = f & 1; const int e = r >> 10, q = r & 1023, rb = q & 63, kb = q >> 6;
            unsigned char* dst = o + (size_t)e * 4096 * DM + (size_t)(64 * rb + 32 * h) * DM + 128 * kb;
            LDS_WAIT(); asm volatile("" ::: "memory");
            const int c = ln & 7, n0 = ln >> 3;
#pragma unroll
            for (int j2 = 0; j2 < 4; ++j2) { const int n = n0 + 8 * j2; const u32x4 ov = *(const LAS u32x4*)(scr + n * 144 + c * 16);
                __builtin_nontemporal_store(ov, (u32x4*)(dst + (size_t)n * DM + 16 * c)); }
        }
        LDS_WAIT(); asm volatile("" ::: "memory");
    }
};

__device__ __forceinline__ void p2a_mlstm_prep(Frame& F) {
    const int gw = F.vcu * NWAVES + F.wave, NGW = F.G * NWAVES, lane = F.lane;
    const bf16_t* Z = (const bf16_t*)(F.ws + WS_Z);
    bf16_t* QM = (bf16_t*)(F.ws + WS_QM); bf16_t* KM = (bf16_t*)(F.ws + WS_KM); bf16_t* KT = (bf16_t*)(F.ws + WS_KT); bf16_t* VT = (bf16_t*)(F.ws + WS_VT);
    const float* conv_w = F.in[3]; const float* conv_b = F.in[4];
    const int cg = lane & 7, tg = lane >> 3;
    for (int it = gw; it < 48 * 128; it += NGW) {
        const int cb = it % 48, tb = it / 48;
        const int ch = 64 * cb + 8 * cg;
        const int t0 = 64 * tb + 8 * tg;
        float y[8][8];
        if (cb < 32) {
            float x[12][8];
#pragma unroll
            for (int r = 0; r < 12; ++r) { const int t = t0 + r - 2;
                if (t >= 0 && t < S_) { const u32x4 w = *(const u32x4*)(Z + (size_t)t * ZW + ch);
                    x[r][0] = bf_lo(w.x); x[r][1] = bf_hi(w.x); x[r][2] = bf_lo(w.y); x[r][3] = bf_hi(w.y); x[r][4] = bf_lo(w.z); x[r][5] = bf_hi(w.z); x[r][6] = bf_lo(w.w); x[r][7] = bf_hi(w.w); }
                else {
#pragma unroll
                    for (int c = 0; c < 8; ++c) x[r][c] = 0.f; } }
            float cw[5][8], cbv[8];
#pragma unroll
            for (int j = 0; j < 5; ++j) { const f32x4 a = *(const f32x4*)(conv_w + j * 2048 + ch), b = *(const f32x4*)(conv_w + j * 2048 + ch + 4);
                cw[j][0] = a.x; cw[j][1] = a.y; cw[j][2] = a.z; cw[j][3] = a.w; cw[j][4] = b.x; cw[j][5] = b.y; cw[j][6] = b.z; cw[j][7] = b.w; }
            { const f32x4 a = *(const f32x4*)(conv_b + ch), b = *(const f32x4*)(conv_b + ch + 4); cbv[0] = a.x; cbv[1] = a.y; cbv[2] = a.z; cbv[3] = a.w; cbv[4] = b.x; cbv[5] = b.y; cbv[6] = b.z; cbv[7] = b.w; }
            const float osc = (cb < 16) ? 0.0625f : 1.0f;
#pragma unroll
            for (int t = 0; t < 8; ++t)
#pragma unroll
                for (int c = 0; c < 8; ++c) { float s = cbv[c];
#pragma unroll
                    for (int j = 0; j < 5; ++j) s = fmaf(cw[j][c], x[t + j][c], s);
                    y[t][c] = s * sigmoidf_(s) * osc; }
            bf16_t* RM = (cb < 16) ? (QM + ch) : (KM + (ch - 1024));
#pragma unroll
            for (int t = 0; t < 8; ++t) { u32x4 w; w.x = cvt_pk_bf16(y[t][0], y[t][1]); w.y = cvt_pk_bf16(y[t][2], y[t][3]); w.z = cvt_pk_bf16(y[t][4], y[t][5]); w.w = cvt_pk_bf16(y[t][6], y[t][7]);
                *(u32x4*)(RM + (size_t)(t0 + t) * AW) = w; }
        } else {
#pragma unroll
            for (int t = 0; t < 8; ++t) { const u32x4 w = *(const u32x4*)(Z + (size_t)(t0 + t) * ZW + ch);
                y[t][0] = bf_lo(w.x); y[t][1] = bf_hi(w.x); y[t][2] = bf_lo(w.y); y[t][3] = bf_hi(w.y); y[t][4] = bf_lo(w.z); y[t][5] = bf_hi(w.z); y[t][6] = bf_lo(w.w); y[t][7] = bf_hi(w.w); }
        }
        if (cb >= 16) {
            bf16_t* TT = (cb < 32) ? (KT + (size_t)(ch - 1024) * S_) : (VT + (size_t)(ch - 2048) * S_);
#pragma unroll
            for (int c = 0; c < 8; ++c) { u32x4 w; w.x = cvt_pk_bf16(y[0][c], y[1][c]); w.y = cvt_pk_bf16(y[2][c], y[3][c]); w.z = cvt_pk_bf16(y[4][c], y[5][c]); w.w = cvt_pk_bf16(y[6][c], y[7][c]);
                *(u32x4*)(TT + (size_t)c * S_ + t0) = w; }
        }
    }
}

__device__ __forceinline__ void p2b_attn_prep(Frame& F) {
    const int gw = F.vcu * NWAVES + F.wave, NGW = F.G * NWAVES, lane = F.lane, j2 = 2 * (lane & 15);
    const bf16_t* Z = (const bf16_t*)(F.ws + WS_Z);
    bf16_t* QB = (bf16_t*)(F.ws + WS_QB); bf16_t* KB = (bf16_t*)(F.ws + WS_KB); bf16_t* VB = (bf16_t*)(F.ws + WS_VB);
    const float* qg = F.in[7]; const float* kg = F.in[8];
    const float if0 = exp2f(-(float)j2 * (13.287712379549449f / 32.0f)), if1 = exp2f(-(float)(j2 + 1) * (13.287712379549449f / 32.0f));
    float gq[8], gk[8];
#pragma unroll
    for (int qd = 0; qd < 4; ++qd) { gq[2 * qd] = qg[32 * qd + j2]; gq[2 * qd + 1] = qg[32 * qd + j2 + 1]; gk[2 * qd] = kg[32 * qd + j2]; gk[2 * qd + 1] = kg[32 * qd + j2 + 1]; }
    for (int t = 4 * gw + (lane >> 4); t < S_; t += 4 * NGW) {
        const float pr = (float)(t >> 6), pc = (float)(t & 63);
        float cr0, sr0, cr1, sr1, cc0, sc0, cc1, sc1;
        sincosf(pr * if0, &sr0, &cr0); sincosf(pr * if1, &sr1, &cr1); sincosf(pc * if0, &sc0, &cc0); sincosf(pc * if1, &sc1, &cc1);
        const bf16_t* zr = Z + (size_t)t * ZW;
        unsigned raw[10][4];
#pragma unroll
        for (int j = 0; j < 10; ++j) { const bf16_t* src = (j < 8) ? (zr + ZC_QB + 128 * j) : (zr + ZC_KB + 128 * (j - 8));
#pragma unroll
            for (int qd = 0; qd < 4; ++qd) raw[j][qd] = *(const unsigned*)(src + 32 * qd + j2); }
        const u32x4 vv = *(const u32x4*)(zr + ZC_VB + 8 * (lane & 15)), vv2 = *(const u32x4*)(zr + ZC_VB + 128 + 8 * (lane & 15));
#pragma unroll
        for (int j = 0; j < 10; ++j) {
            float x[8];
#pragma unroll
            for (int qd = 0; qd < 4; ++qd) { x[2 * qd] = bf_lo(raw[j][qd]); x[2 * qd + 1] = bf_hi(raw[j][qd]); }
            float ss = 0.f;
#pragma unroll
            for (int i = 0; i < 8; ++i) ss = fmaf(x[i], x[i], ss);
            ss += __shfl_xor(ss, 1); ss += __shfl_xor(ss, 2); ss += __shfl_xor(ss, 4); ss += __shfl_xor(ss, 8);
            const float rstd = __builtin_amdgcn_rsqf(ss * (1.f / 128.f) + NORM_EPS);
#pragma unroll
            for (int i = 0; i < 8; ++i) x[i] *= rstd * ((j < 8) ? gq[i] : gk[i]);
            const float o00 = x[0] * cr0 - x[2] * sr0, o01 = x[1] * cr1 - x[3] * sr1, o10 = x[0] * sr0 + x[2] * cr0, o11 = x[1] * sr1 + x[3] * cr1;
            const float o20 = x[4] * cc0 - x[6] * sc0, o21 = x[5] * cc1 - x[7] * sc1, o30 = x[4] * sc0 + x[6] * cc0, o31 = x[5] * sc1 + x[7] * cc1;
            bf16_t* dst = (j < 8) ? (QB + (size_t)t * BW + 128 * j) : (KB + (size_t)t * BKW + 128 * (j - 8));
            *(unsigned*)(dst + j2) = cvt_pk_bf16(o00, o01); *(unsigned*)(dst + 32 + j2) = cvt_pk_bf16(o10, o11); *(unsigned*)(dst + 64 + j2) = cvt_pk_bf16(o20, o21); *(unsigned*)(dst + 96 + j2) = cvt_pk_bf16(o30, o31);
        }
        *(u32x4*)(VB + (size_t)t * BKW + 8 * (lane & 15)) = vv; *(u32x4*)(VB + (size_t)t * BKW + 128 + 8 * (lane & 15)) = vv2;
    }
}

__device__ __forceinline__ float log_sigmoid_(float x) { return fminf(x, 0.f) - log1pf(__expf(-fabsf(x))); }
__device__ __forceinline__ void p2c_gate_prep(Frame& F) {
    const int gw = F.vcu * NWAVES + F.wave, NGW = F.G * NWAVES, lane = F.lane;
    const float* GT = (const float*)(F.ws + WS_GATES); const float* bg = F.in[5];
    float* GA = (float*)(F.ws + WS_GA); float* GBV = (float*)(F.ws + WS_GBV); float* GCM = (float*)(F.ws + WS_GCM);
    float* BC = (float*)(F.ws + WS_CHK); float* AMAX = BC + 512;
    for (int task = gw; task < 4 * NCH * 8; task += NGW) {
        if (task & 3) continue;
        const int c = (task >> 2) >> 3, dir = ((task >> 2) >> 2) & 1, h = (task >> 2) & 3;
        const int t0 = ACH * c + 2 * lane;
            {
                const int gi = dir * 8 + h, gf = dir * 8 + 4 + h;
                const float i0 = GT[(size_t)t0 * 16 + gi] + bg[gi], i1 = GT[(size_t)(t0 + 1) * 16 + gi] + bg[gi];
                const float l0 = log_sigmoid_(GT[(size_t)t0 * 16 + gf] + bg[gf]), l1 = log_sigmoid_(GT[(size_t)(t0 + 1) * 16 + gf] + bg[gf]);
                float tot = l0 + l1, sc = tot;
#pragma unroll
                for (int o = 1; o < 64; o <<= 1) { const float v = dir ? __shfl_down(sc, o) : __shfl_up(sc, o); if (dir ? (lane + o < 64) : (lane >= o)) sc += v; }
                const float ex = sc - tot;
                float b0, b1;
                if (dir == 0) { b0 = ex + l0; b1 = ex + l0 + l1; } else { b1 = ex + l1; b0 = ex + l1 + l0; }
                const float a0 = i0 - b0, a1 = i1 - b1;
                float mx = fmaxf(a0, a1), sm = mx;
#pragma unroll
                for (int o = 1; o < 64; o <<= 1) { const float v = dir ? __shfl_down(sm, o) : __shfl_up(sm, o); if (dir ? (lane + o < 64) : (lane >= o)) sm = fmaxf(sm, v); }
                float exm = dir ? __shfl_down(sm, 1) : __shfl_up(sm, 1); if (dir ? (lane == 63) : (lane == 0)) exm = -3.0e38f;
                float c0, c1;
                if (dir == 0) { c0 = fmaxf(exm, a0); c1 = fmaxf(c0, a1); } else { c1 = fmaxf(exm, a1); c0 = fmaxf(c1, a0); }
                const size_t o = (size_t)(dir * 4 + h) * S_ + t0;
                *(f32x2*)(GA + o) = (f32x2){a0, a1}; *(f32x2*)(GBV + o) = (f32x2){b0, b1}; *(f32x2*)(GCM + o) = (f32x2){c0, c1};
                const float btot = wave_sum(tot), amax = wave_max(mx);
                if (lane == 0) { BC[(dir * 4 + h) * NCH + c] = btot; AMAX[(dir * 4 + h) * NCH + c] = amax; }
            }
    }
}

constexpr int P3_WK = 0, P3_MC = 32768, P3_DEC = 33024, P3_KS = 33280, P3_KSB = 32 * 272;
#define P3_LOAD(AV, KR, c_) do { const int s0_ = ACH * (c_); _Pragma("unroll") for (int ks = 0; ks < 4; ++ks) AV[ks] = *(const bf16x8*)(vrow + s0_ + 32 * ks); KR = *(const u32x4*)(krow + s0_); } while (0)
#define P3_STEP(AV, KR, c_, buf_) do { const int cc = (c_); const float decay = decl[cc]; \
        { const LAS float* wp = wkl + ACH * cc + 8 * sg; const f32x4 g0 = *(const LAS f32x4*)wp, g1 = *(const LAS f32x4*)(wp + 4); const u32x4 kw = KR; \
          const float k0 = bf_lo(kw.x) * g0.x, k1 = bf_hi(kw.x) * g0.y, k2 = bf_lo(kw.y) * g0.z, k3 = bf_hi(kw.y) * g0.w, k4 = bf_lo(kw.z) * g1.x, k5 = bf_hi(kw.z) * g1.y, k6 = bf_lo(kw.w) * g1.z, k7 = bf_hi(kw.w) * g1.w; \
          u32x4 bw; bw.x = cvt_pk_bf16(k0, k1); bw.y = cvt_pk_bf16(k2, k3); bw.z = cvt_pk_bf16(k4, k5); bw.w = cvt_pk_bf16(k6, k7); \
          *(LAS u32x4*)(F.lds + P3_KS + (buf_) * P3_KSB + dd * 272 + sg * 16) = bw; \
          if (et == 0) { float ns = ((k0 + k1) + (k2 + k3)) + ((k4 + k5) + (k6 + k7)); ns += __shfl_xor(ns, 1); ns += __shfl_xor(ns, 2); ns += __shfl_xor(ns, 4); ns += __shfl_xor(ns, 8); \
              if (sg == 0) NS[(size_t)(dh * NCH + cc) * 256 + 32 * dt + dd] = nacc; nacc = nacc * decay + ns; } } \
        bf16_t* ct = CT + ((size_t)(dh * NCH + cc) * 256 + e0 + 4 * kq) * 256 + d0 + cI; \
        _Pragma("unroll") for (int r = 0; r < 4; ++r) __builtin_nontemporal_store(f2bf(acc[r]), ct + (size_t)r * 256);     \
        acc *= decay; \
        asm volatile("s_waitcnt lgkmcnt(0)" ::: "memory"); __builtin_amdgcn_s_barrier(); asm volatile("" ::: "memory"); \
        _Pragma("unroll") for (int ks = 0; ks < 4; ++ks) { const bf16x8 bfr = *(const LAS bf16x8*)(F.lds + P3_KS + (buf_) * P3_KSB + (16 * (F.wave & 1) + cI) * 272 + ks * 64 + kq * 16); \
            acc = __builtin_amdgcn_mfma_f32_16x16x32_bf16(AV[ks], bfr, acc, 0, 0, 0); } } while (0)
__device__ __forceinline__ void p3_state_scan(Frame& F) {
    const int lane = F.lane, cI = lane & 15, kq = lane >> 4, dd = F.tid >> 4, sg = F.tid & 15;
    const bf16_t* KT = (const bf16_t*)(F.ws + WS_KT); const bf16_t* VT = (const bf16_t*)(F.ws + WS_VT);
    const float* GA = (const float*)(F.ws + WS_GA);
    const float* BC = (const float*)(F.ws + WS_CHK); const float* AMAX = BC + 512; float* MS = (float*)(F.ws + WS_CHK) + 1024;
    bf16_t* CT = (bf16_t*)(F.ws + WS_CT); float* NS = (float*)(F.ws + WS_NS);
    LAS float* wkl = (LAS float*)(F.lds + P3_WK); LAS float* mcl = (LAS float*)(F.lds + P3_MC); LAS float* decl = (LAS float*)(F.lds + P3_DEC);
    for (int pi = F.vcu; pi < 256; pi += F.G) {
        const int dh = pi >> 5, dir = dh >> 2, h = dh & 3;
        if (F.wave == 0) {
            const int c = dir ? (NCH - 1 - lane) : lane;
            const float amax = AMAX[dh * NCH + c]; float P = BC[dh * NCH + c], Q = amax + P;
#pragma unroll
            for (int o = 1; o < 64; o <<= 1) { const float Pp = __shfl_up(P, o), Qp = __shfl_up(Q, o); if (lane >= o) { Q = fmaxf(Qp + P, Q); P = Pp + P; } }
            const float mout = fmaxf(P, Q);
            float min_ = __shfl_up(mout, 1); if (lane == 0) min_ = 0.f;
            const float Mc = fmaxf(min_, amax);
            mcl[c] = Mc; decl[c] = __expf(min_ - Mc);
            if ((pi & 31) == 0) MS[dh * NCH + c] = min_;
        }
        __syncthreads();
        { const float* ga = GA + (size_t)dh * S_;
#pragma unroll
          for (int i = 0; i < 16; ++i) { const int s = F.tid + 512 * i; wkl[s] = __expf(ga[s] - mcl[s >> 7]); } }
        __syncthreads();
        {
            const int et = (pi >> 3) & 3, dt = pi & 7, e0 = 64 * et + 16 * (F.wave >> 1), d0 = 32 * dt + 16 * (F.wave & 1);
            const bf16_t* vrow = VT + (size_t)(h * 256 + e0 + cI) * S_ + 8 * kq;
            const bf16_t* krow = KT + (size_t)(h * 256 + 32 * dt + dd) * S_ + 8 * sg;
            f32x4 acc = (f32x4){0.f, 0.f, 0.f, 0.f}; float nacc = 0.f;
            bf16x8 av0[4], av1[4], av2[4], av3[4]; u32x4 kr0, kr1, kr2, kr3;
#define P3_C(st_) (dir ? (NCH - 1 - (st_)) : (st_))
            P3_LOAD(av0, kr0, P3_C(0)); P3_LOAD(av1, kr1, P3_C(1)); P3_LOAD(av2, kr2, P3_C(2));
            for (int st = 0; st < NCH; st += 4) {
                P3_LOAD(av3, kr3, P3_C(st + 3));
                P3_STEP(av0, kr0, P3_C(st), 0);
                if (st + 4 < NCH) P3_LOAD(av0, kr0, P3_C(st + 4));
                P3_STEP(av1, kr1, P3_C(st + 1), 1);
                if (st + 4 < NCH) P3_LOAD(av1, kr1, P3_C(st + 5));
                P3_STEP(av2, kr2, P3_C(st + 2), 0);
                if (st + 4 < NCH) P3_LOAD(av2, kr2, P3_C(st + 6));
                P3_STEP(av3, kr3, P3_C(st + 3), 1);
            }
#undef P3_C
        }
        __syncthreads();
    }
}
#undef P3_LOAD
#undef P3_STEP
constexpr int ML_QL = 0, ML_KL = 65536, ML_ALF = RING_BYTES + 2048, ML_ALB = ML_ALF + 512, ML_RSTD = ML_ALB + 512, ML_SSP = RING_BYTES + 4096, ML_NL = RING_BYTES + 12288;
__device__ __forceinline__ void mlstm_out_unit(Frame& F, int h, int c) {
    const int lane = F.lane, w = F.wave, tid = F.tid, cI = lane & 15, kq = lane >> 4;
    const bf16_t* QM = (const bf16_t*)(F.ws + WS_QM); const bf16_t* KM = (const bf16_t*)(F.ws + WS_KM); const bf16_t* VT = (const bf16_t*)(F.ws + WS_VT);
    const float* GA = (const float*)(F.ws + WS_GA); const float* GBV = (const float*)(F.ws + WS_GBV); const float* GCM = (const float*)(F.ws + WS_GCM);
    const float* MS = (const float*)(F.ws + WS_CHK) + 1024;
    const bf16_t* CT = (const bf16_t*)(F.ws + WS_CT); const float* NS = (const float*)(F.ws + WS_NS);
    LAS unsigned char* QL = F.lds + ML_QL; LAS unsigned char* KL = F.lds + ML_KL; LAS unsigned char* PL = F.lds + ML_KL;
    LAS float* alfl = (LAS float*)(F.lds + ML_ALF); LAS float* albl = (LAS float*)(F.lds + ML_ALB); LAS float* rstdl = (LAS float*)(F.lds + ML_RSTD); LAS float* sspl = (LAS float*)(F.lds + ML_SSP);
    const int t0 = ACH * c;
    int aq[8], ap[4];
#pragma unroll
    for (int ks = 0; ks < 8; ++ks) aq[ks] = cI * 512 + (((4 * ks + kq) ^ cI) << 4);
#pragma unroll
    for (int k2 = 0; k2 < 4; ++k2) ap[k2] = cI * 272 + 64 * k2 + 16 * kq;
    {
        u32x4 qv[8], kv[8];
#pragma unroll
        for (int j = 0; j < 8; ++j) { const int p = tid + 512 * j, row = p >> 5, ch = p & 31;
            qv[j] = *(const u32x4*)(QM + (size_t)(t0 + row) * AW + h * ADH + 8 * ch); kv[j] = *(const u32x4*)(KM + (size_t)(t0 + row) * AW + h * ADH + 8 * ch); }
#pragma unroll
        for (int j = 0; j < 8; ++j) { const int p = tid + 512 * j, row = p >> 5, ch = p & 31, off = row * 512 + ((ch ^ (row & 15)) << 4);
            *(LAS u32x4*)(QL + off) = qv[j]; *(LAS u32x4*)(KL + off) = kv[j]; }
    }
    LAS float* nl = (LAS float*)(F.lds + ML_NL);
    if (tid < 128) { const int dir = tid >> 6, i4 = (tid & 63) * 4; *(LAS f32x4*)(nl + dir * 256 + i4) = *(const f32x4*)(NS + (size_t)((dir * 4 + h) * NCH + c) * 256 + i4); }
    float Mt[2][4], bt[2][4], mc[2], gaf[8], gab[8];
#pragma unroll
    for (int dir = 0; dir < 2; ++dir) { const int dh = dir * 4 + h; mc[dir] = MS[dh * NCH + c]; const size_t go = (size_t)dh * S_ + t0 + 16 * w + 4 * kq;
        const f32x4 cm = *(const f32x4*)(GCM + go), bb = *(const f32x4*)(GBV + go);
#pragma unroll
        for (int r = 0; r < 4; ++r) { Mt[dir][r] = fmaxf(mc[dir], cm[r]); bt[dir][r] = bb[r]; } }
#pragma unroll
    for (int sb = 0; sb < 8; ++sb) { gaf[sb] = GA[(size_t)h * S_ + t0 + 16 * sb + cI]; gab[sb] = GA[(size_t)(4 + h) * S_ + t0 + 16 * sb + cI]; }
    __syncthreads();
    bf16x8 qf[8];
#pragma unroll
    for (int ks = 0; ks < 8; ++ks) qf[ks] = *(const LAS bf16x8*)(QL + w * 8192 + aq[ks]);
    float qn[2];
#pragma unroll
    for (int dir = 0; dir < 2; ++dir) { float s = 0.f;
#pragma unroll
        for (int ks = 0; ks < 8; ++ks) { const f32x4 n0 = *(const LAS f32x4*)(nl + dir * 256 + 32 * ks + 8 * kq), n1 = *(const LAS f32x4*)(nl + dir * 256 + 32 * ks + 8 * kq + 4); const u32x4 qw = __builtin_bit_cast(u32x4, qf[ks]);
            s += bf_lo(qw.x) * n0.x + bf_hi(qw.x) * n0.y + bf_lo(qw.y) * n0.z + bf_hi(qw.y) * n0.w + bf_lo(qw.z) * n1.x + bf_hi(qw.z) * n1.y + bf_lo(qw.w) * n1.z + bf_hi(qw.w) * n1.w; }
        s += __shfl_xor(s, 16); s += __shfl_xor(s, 32); qn[dir] = s; }
    __builtin_amdgcn_sched_barrier(0);
    float wf[8][4], wb[8][4], rsf[4] = {0.f, 0.f, 0.f, 0.f}, rsb[4] = {0.f, 0.f, 0.f, 0.f};
#pragma unroll
    for (int sb = 0; sb < 8; ++sb) {
        f32x4 sa = (f32x4){0.f, 0.f, 0.f, 0.f};
#pragma unroll
        for (int ks = 0; ks < 8; ++ks) { const bf16x8 kf = *(const LAS bf16x8*)(KL + sb * 8192 + aq[ks]); sa = __builtin_amdgcn_mfma_f32_16x16x32_bf16(qf[ks], kf, sa, 0, 0, 0); }
        const int sc = 16 * sb + cI;
#pragma unroll
        for (int r = 0; r < 4; ++r) { const int tr = 16 * w + 4 * kq + r;
            const float vf = (sc <= tr) ? __expf(gaf[sb] - Mt[0][r]) * sa[r] : 0.f, vb = (sc >= tr) ? __expf(gab[sb] - Mt[1][r]) * sa[r] : 0.f;
            wf[sb][r] = vf; wb[sb][r] = vb; rsf[r] += vf; rsb[r] += vb; }
        __builtin_amdgcn_sched_barrier(0);
    }
    float invf[4], invb[4];
#pragma unroll
    for (int r = 0; r < 4; ++r) {
        const float qnf = __shfl(qn[0], 4 * kq + r), qnb = __shfl(qn[1], 4 * kq + r);
        float s = rsf[r]; s += __shfl_xor(s, 1); s += __shfl_xor(s, 2); s += __shfl_xor(s, 4); s += __shfl_xor(s, 8);
        float sint = __expf(mc[0] - Mt[0][r]); float den = s + sint * qnf; float N = fmaxf(fabsf(den), __expf(-(bt[0][r] + Mt[0][r]))); invf[r] = 1.0f / N; const float af = sint * invf[r];
        s = rsb[r]; s += __shfl_xor(s, 1); s += __shfl_xor(s, 2); s += __shfl_xor(s, 4); s += __shfl_xor(s, 8);
        sint = __expf(mc[1] - Mt[1][r]); den = s + sint * qnb; N = fmaxf(fabsf(den), __expf(-(bt[1][r] + Mt[1][r]))); invb[r] = 1.0f / N; const float ab = sint * invb[r];
        if (cI == 0) { alfl[16 * w + 4 * kq + r] = af; albl[16 * w + 4 * kq + r] = ab; } }
    __syncthreads();
#pragma unroll
    for (int sb = 0; sb < 8; ++sb)
#pragma unroll
        for (int r = 0; r < 4; ++r) *(LAS bf16_t*)(PL + (16 * w + 4 * kq) * 272 + 2 * cI + r * 272 + sb * 32) = f2bf(wf[sb][r] * invf[r] + wb[sb][r] * invb[r]);
    __syncthreads();
    float outv[2][8][4];
#pragma unroll
    for (int cb = 0; cb < 2; ++cb) {
        const int e = 32 * w + 16 * cb + cI;
        bf16x8 bv[4], bcf[8], bcb[8];
        { const bf16_t* vp = VT + (size_t)(h * ADH + e) * S_ + t0 + 8 * kq; const bf16_t* cf = CT + (size_t)(h * NCH + c) * 65536 + (size_t)e * 256 + 8 * kq; const bf16_t* cbp = CT + (size_t)((4 + h) * NCH + c) * 65536 + (size_t)e * 256 + 8 * kq;
#pragma unroll
          for (int k2 = 0; k2 < 4; ++k2) bv[k2] = *(const bf16x8*)(vp + 32 * k2);
#pragma unroll
          for (int ks = 0; ks < 8; ++ks) { bcf[ks] = *(const bf16x8*)(cf + 32 * ks); bcb[ks] = *(const bf16x8*)(cbp + 32 * ks); } }
#pragma unroll
        for (int rb = 0; rb < 8; ++rb) {
            f32x4 oP = (f32x4){0.f, 0.f, 0.f, 0.f}, oF = oP, oB = oP;
#pragma unroll
            for (int k2 = 0; k2 < 4; ++k2) { const bf16x8 pa = *(const LAS bf16x8*)(PL + rb * 4352 + ap[k2]); oP = __builtin_amdgcn_mfma_f32_16x16x32_bf16(pa, bv[k2], oP, 0, 0, 0); }
#pragma unroll
            for (int ks = 0; ks < 8; ++ks) { const bf16x8 qa = *(const LAS bf16x8*)(QL + rb * 8192 + aq[ks]);
                oF = __builtin_amdgcn_mfma_f32_16x16x32_bf16(qa, bcf[ks], oF, 0, 0, 0); oB = __builtin_amdgcn_mfma_f32_16x16x32_bf16(qa, bcb[ks], oB, 0, 0, 0); }
            const f32x4 af = *(const LAS f32x4*)(alfl + 16 * rb + 4 * kq), ab = *(const LAS f32x4*)(albl + 16 * rb + 4 * kq);
#pragma unroll
            for (int r = 0; r < 4; ++r) { const float o = oP[r] + af[r] * oF[r] + ab[r] * oB[r]; outv[cb][rb][r] = o; float q = o * o; q += __shfl_xor(q, 1); q += __shfl_xor(q, 2); q += __shfl_xor(q, 4); q += __shfl_xor(q, 8);
                if (cI == 0) sspl[(2 * w + cb) * 128 + 16 * rb + 4 * kq + r] = q; }
            __builtin_amdgcn_sched_barrier(0);
        }
    }
    __syncthreads();
    if (tid < 128) { float s = 0.f;
#pragma unroll
        for (int ww = 0; ww < 16; ++ww) s += sspl[ww * 128 + tid];
        rstdl[tid] = 1.0f / sqrtf(s * (1.f / 256.f) + NORM_EPS); }
    __syncthreads();
    const float* norm_g = F.in[6]; LAS float* OL = (LAS float*)F.lds;
#pragma unroll
    for (int cb = 0; cb < 2; ++cb) { const int col = 32 * w + 16 * cb + cI; const float g = norm_g[h * ADH + col];
#pragma unroll
        for (int rb = 0; rb < 8; ++rb) { const f32x4 rs = *(const LAS f32x4*)(rstdl + 16 * rb + 4 * kq);
#pragma unroll
            for (int r = 0; r < 4; ++r) OL[(16 * rb + 4 * kq + r) * 256 + col] = outv[cb][rb][r] * rs[r] * g; } }
    __syncthreads();
    const bf16_t* Z = (const bf16_t*)(F.ws + WS_Z); bf16_t* YA = (bf16_t*)(F.ws + WS_YA);
#pragma unroll 2
    for (int j = 0; j < 8; ++j) { const int p = tid + 512 * j, row = p >> 5, ch = p & 31;
        const f32x4 x0 = *(const LAS f32x4*)(OL + row * 256 + 8 * ch), x1 = *(const LAS f32x4*)(OL + row * 256 + 8 * ch + 4);
        const u32x4 so = *(const u32x4*)(Z + (size_t)(t0 + row) * ZW + ZC_OA + h * ADH + 8 * ch);
        u32x4 o; o.x = cvt_pk_bf16(x0.x * bf_lo(so.x), x0.y * bf_hi(so.x)); o.y = cvt_pk_bf16(x0.z * bf_lo(so.y), x0.w * bf_hi(so.y)); o.z = cvt_pk_bf16(x1.x * bf_lo(so.z), x1.y * bf_hi(so.z)); o.w = cvt_pk_bf16(x1.z * bf_lo(so.w), x1.w * bf_hi(so.w));
        *(u32x4*)(YA + (size_t)(t0 + row) * AW + h * ADH + 8 * ch) = o; }
    __syncthreads();
}
using pg8::Unit;
struct OrderPlain {
    const char* A; const char* B; size_t tstep; int nM, nN, G, c;
    __device__ __forceinline__ bool next(int i, Unit& u) const { u.aux = 0; return pg8::static_tile(i * G + c, nM, nN, u.pm, u.pn); }
    __device__ __forceinline__ const char* a_ptr(const Unit& u) const { return A + (size_t)u.pm * tstep; }
    __device__ __forceinline__ const char* b_ptr(const Unit& u) const { return B + (size_t)u.pn * tstep; }
};
struct OrderProj {
    const char *A0, *B0; long dA, dB; size_t tstep; int nM, nN, G, c;
    __device__ __forceinline__ bool next(int i, Unit& u) const { u.aux = i & 1; return pg8::static_tile((i >> 1) * G + c, nM, nN, u.pm, u.pn); }
    __device__ __forceinline__ const char* a_ptr(const Unit& u) const { return A0 + (long)u.aux * dA + (size_t)u.pm * tstep; }
    __device__ __forceinline__ const char* b_ptr(const Unit& u) const { return B0 + (long)u.aux * dB + (size_t)u.pn * tstep; }
};
struct OrderMoe {
    const char* A; const char* B; size_t tstep, estep; int nN, G, c; const LAS int* tile_e;
    __device__ __forceinline__ bool next(int i, Unit& u) const {
        const int nM = tile_e[255], nwg = nM * nN, L = i * G + c; if (L >= nwg) return false;
        int wgid = L; { const int q = nwg / 8, r = nwg % 8, xcd = wgid % 8, off = wgid / 8; wgid = (xcd < r ? xcd * (q + 1) : r * (q + 1) + (xcd - r) * q) + off; }
        u.pm = __builtin_amdgcn_readfirstlane(wgid / nN); u.pn = __builtin_amdgcn_readfirstlane(wgid % nN); u.aux = __builtin_amdgcn_readfirstlane(tile_e[u.pm]); return true; }
    __device__ __forceinline__ const char* a_ptr(const Unit& u) const { return A + (size_t)u.pm * tstep; }
    __device__ __forceinline__ const char* b_ptr(const Unit& u) const { return B + (size_t)u.aux * estep + (size_t)u.pn * tstep; }
};

struct NoPre {};
struct EpiZ {
    static constexpr bool PERM = true, CHAIN = false; typedef NoPre Pre;
    bf16_t* Z; float* GT;
    __device__ __forceinline__ void prefetch(Pre&, const Unit&, int, int, int, int) const {}
    __device__ __forceinline__ void operator()(const f32x4 (&acc)[2][2][4][2], const Unit& u, int wr, int wc, int fr, int fq, const Pre&) const {
        const int row0 = u.pm * 256 + wr * 64 + fr;
        if (u.pn == 38) {
            if (wc == 0 && fq < 2) {
#pragma unroll
                for (int ai = 0; ai < 2; ++ai)
#pragma unroll
                    for (int m = 0; m < 4; ++m) { float* gp = GT + (size_t)(row0 + ai * 128 + m * 16) * 16 + 8 * fq; *(f32x4*)gp = acc[ai][0][m][0]; *(f32x4*)(gp + 4) = acc[ai][0][m][1]; } }
            return; }
        const bool sg = (u.pn >= 12 && u.pn < 16) || (u.pn >= 22);
        const int col0 = u.pn * 256 + wc * 32 + 8 * fq;
#pragma unroll
        for (int ai = 0; ai < 2; ++ai)
#pragma unroll
            for (int m = 0; m < 4; ++m) { bf16_t* rowp = Z + (size_t)(row0 + ai * 128 + m * 16) * ZW + col0;
#pragma unroll
                for (int bj = 0; bj < 2; ++bj) { f32x4 v0 = acc[ai][bj][m][0], v1 = acc[ai][bj][m][1];
                    if (sg) {
#pragma unroll
                        for (int j = 0; j < 4; ++j) { v0[j] = sigmoidf_(v0[j]); v1[j] = sigmoidf_(v1[j]); } }
                    u32x4 w; w.x = cvt_pk_bf16(v0[0], v0[1]); w.y = cvt_pk_bf16(v0[2], v0[3]); w.z = cvt_pk_bf16(v1[0], v1[1]); w.w = cvt_pk_bf16(v1[2], v1[3]);
                    *(u32x4*)(rowp + bj * 128) = w; } }
    }
};
struct EpiProj {
    static constexpr bool PERM = true, CHAIN = true; typedef NoPre Pre;
    const bf16_t* Z; bf16_t* MIX;
    __device__ __forceinline__ void prefetch(Pre&, const Unit&, int, int, int, int) const {}
    __device__ __forceinline__ void mid(f32x4 (&acc)[2][2][4][2], const Unit& u, int wr, int wc, int fr, int fq) const {
        const int row0 = u.pm * 256 + wr * 64 + fr, col0 = u.pn * 256 + wc * 32 + 8 * fq;
#pragma unroll
        for (int ai = 0; ai < 2; ++ai)
#pragma unroll
            for (int m = 0; m < 4; ++m) { const size_t row = (size_t)(row0 + ai * 128 + m * 16);
#pragma unroll
                for (int bj = 0; bj < 2; ++bj) { const u32x4 ga = *(const u32x4*)(Z + row * ZW + ZC_GA + col0 + bj * 128), gb = *(const u32x4*)(Z + row * ZW + ZC_GB + col0 + bj * 128);
                    f32x4& v0 = acc[ai][bj][m][0]; f32x4& v1 = acc[ai][bj][m][1];
                    v0[0] *= bf_lo(ga.x) * __builtin_amdgcn_rcpf(bf_lo(gb.x)); v0[1] *= bf_hi(ga.x) * __builtin_amdgcn_rcpf(bf_hi(gb.x)); v0[2] *= bf_lo(ga.y) * __builtin_amdgcn_rcpf(bf_lo(gb.y)); v0[3] *= bf_hi(ga.y) * __builtin_amdgcn_rcpf(bf_hi(gb.y));
                    v1[0] *= bf_lo(ga.z) * __builtin_amdgcn_rcpf(bf_lo(gb.z)); v1[1] *= bf_hi(ga.z) * __builtin_amdgcn_rcpf(bf_hi(gb.z)); v1[2] *= bf_lo(ga.w) * __builtin_amdgcn_rcpf(bf_lo(gb.w)); v1[3] *= bf_hi(ga.w) * __builtin_amdgcn_rcpf(bf_hi(gb.w)); } }
    }
    __device__ __forceinline__ void operator()(const f32x4 (&acc)[2][2][4][2], const Unit& u, int wr, int wc, int fr, int fq, const Pre&) const {
        const int row0 = u.pm * 256 + wr * 64 + fr, col0 = u.pn * 256 + wc * 32 + 8 * fq;
#pragma unroll
        for (int ai = 0; ai < 2; ++ai)
#pragma unroll
            for (int m = 0; m < 4; ++m) { const size_t row = (size_t)(row0 + ai * 128 + m * 16);
#pragma unroll
                for (int bj = 0; bj < 2; ++bj) { const u32x4 g = *(const u32x4*)(Z + row * ZW + ZC_GB + col0 + bj * 128);
                    const f32x4 v0 = acc[ai][bj][m][0], v1 = acc[ai][bj][m][1];
                    u32x4 w; w.x = cvt_pk_bf16(v0[0] * bf_lo(g.x), v0[1] * bf_hi(g.x)); w.y = cvt_pk_bf16(v0[2] * bf_lo(g.y), v0[3] * bf_hi(g.y)); w.z = cvt_pk_bf16(v1[0] * bf_lo(g.z), v1[1] * bf_hi(g.z)); w.w = cvt_pk_bf16(v1[2] * bf_lo(g.w), v1[3] * bf_hi(g.w));
                    *(u32x4*)(MIX + row * DM + col0 + bj * 128) = w; } }
    }
};
struct EpiRes {
    static constexpr bool PERM = false, CHAIN = false; typedef NoPre Pre;
    const float* X; float* H;
    __device__ __forceinline__ void prefetch(Pre&, const Unit&, int, int, int, int) const {}
    __device__ __forceinline__ void operator()(const f32x4 (&acc)[2][2][4][2], const Unit& u, int wr, int wc, int fr, int fq, const Pre&) const {
        const int row0 = u.pm * 256 + wr * 64 + fr, col0 = u.pn * 256 + wc * 32 + 4 * fq;
#pragma unroll
        for (int ai = 0; ai < 2; ++ai)
#pragma unroll
            for (int m = 0; m < 4; ++m) { const size_t off = (size_t)(row0 + ai * 128 + m * 16) * DM + col0;
#pragma unroll
                for (int bj = 0; bj < 2; ++bj)
#pragma unroll
                    for (int n = 0; n < 2; ++n) *(f32x4*)(H + off + bj * 128 + n * 16) = *(const f32x4*)(X + off + bj * 128 + n * 16) + acc[ai][bj][m][n]; }
    }
};
struct EpiGlu {
    static constexpr bool PERM = true, CHAIN = false; struct Pre { f32x4 bg0, bg1, bu0, bu1; };
    const float* bias; unsigned char* ACT;
    __device__ __forceinline__ void prefetch(Pre& p, const Unit& u, int wr, int wc, int fr, int fq) const {
        const float* bp = bias + (size_t)u.aux * 4096 + u.pn * 128 + wc * 32 + 8 * fq; p.bg0 = *(const f32x4*)bp; p.bg1 = *(const f32x4*)(bp + 4); p.bu0 = *(const f32x4*)(bp + 2048); p.bu1 = *(const f32x4*)(bp + 2052); }
    __device__ __forceinline__ void operator()(const f32x4 (&acc)[2][2][4][2], const Unit& u, int wr, int wc, int fr, int fq, const Pre& p) const {
        const int row0 = u.pm * 256 + wr * 64 + fr, j0 = wc * 32 + 8 * fq, col0 = u.pn * 128 + j0;
        const f32x4 bg0 = p.bg0, bg1 = p.bg1, bu0 = p.bu0, bu1 = p.bu1;
#pragma unroll
        for (int ai = 0; ai < 2; ++ai)
#pragma unroll
            for (int m = 0; m < 4; ++m) { const size_t row = (size_t)(row0 + ai * 128 + m * 16);
                f32x4 o[2];
#pragma unroll
                for (int n = 0; n < 2; ++n) { const f32x4 gt = acc[ai][0][m][n] * W8_INV + (n ? bg1 : bg0), up = acc[ai][1][m][n] * W8_INV + (n ? bu1 : bu0);
#pragma unroll
                    for (int j = 0; j < 4; ++j) { const float g = fminf(gt[j], 7.0f), uu = fminf(fmaxf(up[j], -7.0f), 7.0f); o[n][j] = (uu + 1.0f) * g * sigmoidf_(g * 1.702f); } }
                u32x2 w; w.x = cvt4_fp8(o[0][0], o[0][1], o[0][2], o[0][3]); w.y = cvt4_fp8(o[1][0], o[1][1], o[1][2], o[1][3]);
                *(u32x2*)(ACT + row * DFF + col0) = w; }
    }
};
struct EpiDown {
    static constexpr bool PERM = true, CHAIN = false; typedef NoPre Pre;
    const float* bias; const int* rasg; const float* rw; bf16_t* YS;
    __device__ __forceinline__ void prefetch(Pre&, const Unit&, int, int, int, int) const {}
    __device__ __forceinline__ void operator()(const f32x4 (&acc)[2][2][4][2], const Unit& u, int wr, int wc, int fr, int fq, const Pre&) const {
        const int row0 = u.pm * 256 + wr * 64 + fr, col0 = u.pn * 256 + wc * 32 + 8 * fq;
        const float* bp = bias + (size_t)u.aux * DM + col0;
        int ra[8]; float rwv[8];
#pragma unroll
        for (int i = 0; i < 8; ++i) { const int row = row0 + (i >> 2) * 128 + (i & 3) * 16; ra[i] = rasg[row]; rwv[i] = rw[row]; }
        f32x4 bv[2][2];
#pragma unroll
        for (int bj = 0; bj < 2; ++bj) { bv[bj][0] = *(const f32x4*)(bp + bj * 128); bv[bj][1] = *(const f32x4*)(bp + bj * 128 + 4); }
#pragma unroll
        for (int ai = 0; ai < 2; ++ai)
#pragma unroll
            for (int m = 0; m < 4; ++m) { const int a = ra[ai * 4 + m]; const float wgt = rwv[ai * 4 + m];
                if (a >= 0) {
#pragma unroll
                    for (int bj = 0; bj < 2; ++bj) { const f32x4 v0 = (acc[ai][bj][m][0] * W8_INV + bv[bj][0]) * wgt, v1 = (acc[ai][bj][m][1] * W8_INV + bv[bj][1]) * wgt;
                        u32x4 w; w.x = cvt_pk_bf16(v0[0], v0[1]); w.y = cvt_pk_bf16(v0[2], v0[3]); w.z = cvt_pk_bf16(v1[0], v1[1]); w.w = cvt_pk_bf16(v1[2], v1[3]);
                        *(u32x4*)(YS + (size_t)a * DM + col0 + bj * 128) = w; } } }
    }
};
constexpr int R_TILE = 0, R_PART = 69632, R_SS = 102400, R_RSTD = 103424, R_LOG = 103680, R_HIST = 108032, R_SEL = 108544;
__device__ __forceinline__ void p7_router(Frame& F) {
    const int lane = F.lane, w = F.wave, tid = F.tid, r32 = lane & 31, hi = lane >> 5;
    const float* H1 = (const float*)(F.ws + WS_H1); const float* g = F.in[12]; const float* wrt = F.in[13]; const float* brt = F.in[14];
    unsigned char* U8 = F.ws + WS_U;
    int* TOPI = (int*)(F.ws + WS_TOPI); float* TOPW = (float*)(F.ws + WS_TOPW); int* SLOT = (int*)(F.ws + WS_SLOT); int* HIST = (int*)(F.ws + WS_SLOT + 512 * 1024);
    LAS float* tile = (LAS float*)(F.lds + R_TILE + w * 8320); LAS float* part = (LAS float*)(F.lds + R_PART); LAS float* ssp = (LAS float*)(F.lds + R_SS);
    LAS float* rstdl = (LAS float*)(F.lds + R_RSTD); LAS float* logl = (LAS float*)(F.lds + R_LOG); LAS int* hist = (LAS int*)(F.lds + R_HIST); LAS int* sel = (LAS int*)(F.lds + R_SEL);
    for (int tt = F.vcu; tt < S_ / 32; tt += F.G) {
        const int t0 = 32 * tt;
        if (tid < 64) hist[tid] = 0;
        f32x16 acc = {}; float ss = 0.f;
        for (int sub = 0; sub < 4; ++sub) {
            const int k0 = 256 * w + 64 * sub; const int rr = lane >> 4, cq = lane & 15;
            f32x4 hv[8]; float bw[32], gw_[32];
#pragma unroll
            for (int it = 0; it < 8; ++it) hv[it] = *(const f32x4*)(H1 + (size_t)(t0 + 4 * it + rr) * DM + k0 + 4 * cq);
#pragma unroll
            for (int kk = 0; kk < 32; ++kk) { const int k = k0 + 2 * kk + hi; bw[kk] = wrt[(size_t)k * NE + r32]; gw_[kk] = g[k]; }
#pragma unroll
            for (int it = 0; it < 8; ++it) { LAS float* tp = tile + (4 * it + rr) * 65 + 4 * cq; tp[0] = hv[it].x; tp[1] = hv[it].y; tp[2] = hv[it].z; tp[3] = hv[it].w; }
            LDS_WAIT(); asm volatile("" ::: "memory");
#pragma unroll
            for (int kk = 0; kk < 32; ++kk) { const float a = tile[r32 * 65 + 2 * kk + hi]; const float b = gw_[kk] * bw[kk];
                ss = fmaf(a, a, ss); acc = __builtin_amdgcn_mfma_f32_32x32x2f32(a, b, acc, 0, 0, 0); }
            LDS_WAIT(); asm volatile("" ::: "memory");
        }
        ss += __shfl_xor(ss, 32);
        if (hi == 0) ssp[w * 32 + r32] = ss;
#pragma unroll
        for (int r = 0; r < 16; ++r) part[(w * 32 + ((r & 3) + 8 * (r >> 2) + 4 * hi)) * 32 + r32] = acc[r];
        __syncthreads();
#pragma unroll
        for (int j = 0; j < 2; ++j) { const int idx = tid * 2 + j, t = idx >> 5, e = idx & 31; float s = 0.f, q = 0.f;
#pragma unroll
            for (int ww = 0; ww < 8; ++ww) { s += part[(ww * 32 + t) * 32 + e]; q += ssp[ww * 32 + t]; }
            const float rstd = 1.0f / sqrtf(q * (1.f / 2048.f) + NORM_EPS);
            logl[t * 33 + e] = s * rstd + brt[e]; if (e == 0) rstdl[t] = rstd; }
        __syncthreads();
        if (tid < 32) { const int t = tid; float v[4]; int ix[4]; unsigned used = 0u;
#pragma unroll
            for (int k = 0; k < 4; ++k) { float best = -3.0e38f; int bi = 0;
                for (int e = 0; e < NE; ++e) { const float x = logl[t * 33 + e]; if (!((used >> e) & 1u) && x > best) { best = x; bi = e; } }
                v[k] = best; ix[k] = bi; used |= 1u << bi; }
            const float e1 = __expf(v[1] - v[0]), e2 = __expf(v[2] - v[0]), e3 = __expf(v[3] - v[0]); const float inv = 1.0f / (1.0f + e1 + e2 + e3);
            const float wk[4] = {inv, e1 * inv, e2 * inv, e3 * inv};
#pragma unroll
            for (int k = 0; k < 4; ++k) { TOPI[(t0 + t) * 4 + k] = ix[k]; TOPW[(t0 + t) * 4 + k] = wk[k]; sel[t * 8 + k] = ix[k]; sel[t * 8 + 4 + k] = atomicAdd((int*)&hist[ix[k]], 1); } }
        __syncthreads();
        if (tid < 32) { HIST[tt * 32 + tid] = hist[tid];
#pragma unroll
            for (int k = 0; k < 4; ++k) SLOT[(t0 + tid) * 4 + k] = sel[tid * 8 + 4 + k]; }
#pragma unroll
        for (int rr = 0; rr < 4; ++rr) { const int row = 4 * w + rr; const float rstd = rstdl[row]; const float* xr = H1 + (size_t)(t0 + row) * DM; unsigned char* orow = U8 + (size_t)(t0 + row) * DM;
#pragma unroll
            for (int j = 0; j < 8; ++j) { const f32x4 v = *(const f32x4*)(xr + 256 * j + 4 * lane); const f32x4 gg = *(const f32x4*)(g + 256 * j + 4 * lane);
                *(unsigned*)(orow + 256 * j + 4 * lane) = cvt4_fp8(v.x * rstd * gg.x, v.y * rstd * gg.y, v.z * rstd * gg.z, v.w * rstd * gg.w); } }
        __syncthreads();
    }
}

__device__ __forceinline__ void moe_tables(Frame& F) {
    LAS int* ps = (LAS int*)(F.lds + MISC_OFF + 256); LAS int* te = (LAS int*)(F.lds + TILE_E_OFF);
    if (F.tid == 0) { int cum = 0;
        for (int e = 0; e < NE; ++e) { const int n = (int)__hip_atomic_load(F.ctl + CW_CNT + e, RLX_AGENT); const int nt = (n + 255) >> 8; ps[e] = cum * 256; for (int j = 0; j < nt && cum < 255; ++j) te[cum++] = e; }
        te[255] = cum; }
    __syncthreads();
}
__device__ __forceinline__ void p8_scatter(Frame& F) {
    const int lane = F.lane, tid = F.tid;
    const int* TOPI = (const int*)(F.ws + WS_TOPI); const float* TOPW = (const float*)(F.ws + WS_TOPW); const int* SLOT = (const int*)(F.ws + WS_SLOT); const int* HIST = (const int*)(F.ws + WS_SLOT + 512 * 1024);
    int* rasg = (int*)(F.ws + WS_RASG); float* rw = (float*)(F.ws + WS_RW);
    const unsigned char* U8 = F.ws + WS_U; unsigned char* XG = F.ws + WS_XG;
    LAS int* part = (LAS int*)(F.lds);
    LAS int* rowb = (LAS int*)(F.lds + 4096);
    for (int tt = F.vcu; tt < S_ / 32; tt += F.G) {
        { const int jg = tid >> 5, e = tid & 31; int lt = 0, al = 0;
#pragma unroll
          for (int j = 0; j < 16; ++j) { const int jj = jg * 16 + j; const int v = HIST[jj * 32 + e]; al += v; lt += (jj < tt) ? v : 0; }
          part[(jg * 32 + e) * 2] = lt; part[(jg * 32 + e) * 2 + 1] = al; }
        __syncthreads();
        if (tid < 32) { int lt = 0, al = 0;
#pragma unroll
            for (int jg = 0; jg < 16; ++jg) { lt += part[(jg * 32 + tid) * 2]; al += part[(jg * 32 + tid) * 2 + 1]; }
            const int nt = (al + 255) >> 8; int sc = nt;
#pragma unroll
            for (int o = 1; o < 32; o <<= 1) { const int v = __shfl_up(sc, o); if (tid >= o) sc += v; }
            rowb[tid] = (sc - nt) * 256 + lt;
            if (tt == 0) __hip_atomic_store(F.ctl + CW_CNT + tid, (unsigned)al, RLX_AGENT); }
        __syncthreads();
        { const int a0 = tt * 128 + 16 * F.wave; int rr = 0;
          if (lane < 16) { const int a = a0 + lane; const int e = TOPI[a]; rr = rowb[e] + SLOT[a]; rasg[rr] = a; rw[rr] = TOPW[a]; }
#pragma unroll
          for (int q = 0; q < 4; ++q) { u32x4 v[4][2]; int r[4];
#pragma unroll
              for (int j = 0; j < 4; ++j) { const int i = 4 * q + j, t = (a0 + i) >> 2; r[j] = __shfl(rr, i); const u32x4* src = (const u32x4*)(U8 + (size_t)t * DM); v[j][0] = src[lane]; v[j][1] = src[64 + lane]; }
#pragma unroll
              for (int j = 0; j < 4; ++j) { u32x4* dst = (u32x4*)(XG + (size_t)r[j] * DM); dst[lane] = v[j][0]; dst[64 + lane] = v[j][1]; } } }
        __syncthreads();
    }
}
__device__ __forceinline__ void p11_final(Frame& F) {
    const int gw = F.vcu * NWAVES + F.wave, NGW = F.G * NWAVES, lane = F.lane;
    const float* H1 = (const float*)(F.ws + WS_H1); const bf16_t* YS = (const bf16_t*)(F.ws + WS_YS); const float* g = F.in[19];
    for (int t = gw; t < S_; t += NGW) {
        f32x4 v[8]; float s = 0.f;
#pragma unroll
        for (int j = 0; j < 8; ++j) { v[j] = __builtin_nontemporal_load((const f32x4*)(H1 + (size_t)t * DM + 256 * j + 4 * lane));
#pragma unroll
            for (int k = 0; k < 4; ++k) { const u32x2 y = __builtin_nontemporal_load((const u32x2*)(YS + (size_t)(4 * t + k) * DM + 256 * j + 4 * lane)); v[j].x += bf_lo(y.x); v[j].y += bf_hi(y.x); v[j].z += bf_lo(y.y); v[j].w += bf_hi(y.y); }
            s += (v[j].x * v[j].x + v[j].y * v[j].y) + (v[j].z * v[j].z + v[j].w * v[j].w); }
        const float rstd = 1.0f / sqrtf(wave_sum(s) * (1.f / 2048.f) + NORM_EPS);
#pragma unroll
        for (int j = 0; j < 8; ++j) { const f32x4 gg = *(const f32x4*)(g + 256 * j + 4 * lane); __builtin_nontemporal_store(v[j] * rstd * gg, (f32x4*)(F.out + (size_t)t * DM + 256 * j + 4 * lane)); }
    }
}

__device__ __forceinline__ void ph1(Frame& F) {
    unsigned char* ws = F.ws;
    if (is_converter(F)) { p1_convert(F); return; }
    const bool split = (F.G == 256);
    const int Gg = split ? 8 * (32 - CONV_PER_XCD) : F.G, cg = split ? ((F.vcu & 31) * 8 + (F.vcu >> 5)) : (int)blockIdx.x;
    OrderPlain S{(const char*)(ws + WS_U), (const char*)(ws + WS_WIN), (size_t)256 * DM * 2, S_ / 256, NIN / 256, Gg, cg};
    EpiZ E{(bf16_t*)(ws + WS_Z), (float*)(ws + WS_GATES)};
    pg8::gemm_phase<EpiZ, OrderPlain>(F.lds, DM * 2, S, E);
}
__device__ __forceinline__ void ph2(Frame& F) { p2a_mlstm_prep(F); p2b_attn_prep(F); p2c_gate_prep(F); }
__device__ __forceinline__ void ph4a(Frame& F, char* lds) {
    unsigned char* ws = F.ws;
    const int gw = F.vcu * NWAVES + F.wave;
    const AttnFill fl{F.in[15], ws + WS_WGU, F.lds + (int)attn::SHM_ATTN + F.wave * 4096, F.lds + (F.wave < 6 ? (int)attn::SHM_ATTN + 32768 + F.wave * 4608 : TILE_E_OFF + 1024 + (F.wave - 6) * 4608), 8 * gw, F.lane};
    for (int u = F.vcu; u < BH * (S_ / 256); u += F.G) { const int head = u >> 5, qb = u & 31;
        attn::attn_dense_body((const bf16_t*)(ws + WS_QB) + (size_t)qb * 256 * BW + head * BDH, (const bf16_t*)(ws + WS_KB) + (head >> 2) * BDH, (const bf16_t*)(ws + WS_VB) + (head >> 2) * BDH,
                              (bf16_t*)(ws + WS_YB) + (size_t)qb * 256 * BW + head * BDH, S_, lds, fl);
        __syncthreads(); }
}
__device__ __forceinline__ void ph4b(Frame& F) {
    if (F.vcu < AH * NCH) mlstm_out_unit(F, F.vcu >> 6, F.vcu & 63);
    __syncthreads();
}
__device__ __forceinline__ void ph5(Frame& F) {
    unsigned char* ws = F.ws;
    OrderProj S{(const char*)(ws + WS_YA), (const char*)(ws + WS_WPA), (long)(WS_YB - WS_YA), (long)(WS_WPB - WS_WPA), (size_t)256 * AW * 2, S_ / 256, DM / 256, F.G, (int)blockIdx.x};
    EpiProj E{(const bf16_t*)(ws + WS_Z), (bf16_t*)(ws + WS_MIX)};
    pg8::gemm_phase<EpiProj, OrderProj>(F.lds, AW * 2, S, E);
}
__device__ __forceinline__ void ph6(Frame& F) {
    unsigned char* ws = F.ws;
    OrderPlain S{(const char*)(ws + WS_MIX), (const char*)(ws + WS_WOUT), (size_t)256 * DM * 2, S_ / 256, DM / 256, F.G, (int)blockIdx.x};
    EpiRes E{F.in[0], (float*)(ws + WS_H1)};
    pg8::gemm_phase<EpiRes, OrderPlain>(F.lds, DM * 2, S, E);
}
__device__ __forceinline__ void ph9(Frame& F) {
    unsigned char* ws = F.ws;
    moe_tables(F);
    OrderMoe S{(const char*)(ws + WS_XG), (const char*)(ws + WS_WGU), (size_t)256 * DM, (size_t)4096 * DM, 16, F.G, (int)blockIdx.x, (const LAS int*)(F.lds + TILE_E_OFF)};
    EpiGlu E{F.in[16], ws + WS_ACT};
    pg8::gemm_phase<EpiGlu, OrderMoe, true>(F.lds, DM, S, E);
}
__device__ __forceinline__ void ph10(Frame& F) {
    unsigned char* ws = F.ws;
    moe_tables(F);
    OrderMoe S{(const char*)(ws + WS_ACT), (const char*)(ws + WS_WDN), (size_t)256 * DFF, (size_t)DM * DFF, 8, F.G, (int)blockIdx.x, (const LAS int*)(F.lds + TILE_E_OFF)};
    EpiDown E{F.in[18], (const int*)(ws + WS_RASG), (const float*)(ws + WS_RW), (bf16_t*)(ws + WS_YS)};
    pg8::gemm_phase<EpiDown, OrderMoe, true>(F.lds, DFF, S, E);
}

constexpr int N_PHASES = 12;
struct Args { const float* in[20]; float* out; unsigned char* ws; int ph_lo, ph_hi; };
__global__ void __launch_bounds__(NTHR, 2) fwd_kernel(Args args) {
    extern __shared__ __attribute__((aligned(16))) unsigned char lds[];
    Frame F;
    F.lds = (LAS unsigned char*)lds; F.ws = args.ws; F.ctl = (gu32*)(args.ws + WS_CTL);
    F.tid = threadIdx.x; F.lane = F.tid & 63; F.wave = __builtin_amdgcn_readfirstlane(F.tid >> 6);
    F.G = gridDim.x; { const int bx = blockIdx.x; F.vcu = (F.G % 8 == 0) ? (bx % 8) * (F.G / 8) + bx / 8 : bx; }
#pragma unroll
    for (int i = 0; i < 20; ++i) F.in[i] = args.in[i];
    F.out = args.out;
    volatile LAS unsigned* MISC = (volatile LAS unsigned*)(F.lds + MISC_OFF);
    if (F.tid < 64) MISC[F.tid] = 0u;
    __syncthreads();
    const int lo = args.ph_lo, hi = args.ph_hi;
    XcdBarrier bar; bar.bar = (unsigned*)(F.ctl + CW_BAR); bar.x = 0; bar.st = nullptr;
    if (hi - lo > 1) bar = xcd_barrier_post((unsigned*)(F.ctl + CW_BAR), MISC + 8);
#ifndef PHASE_MASK
#define PHASE_MASK 0xFFF
#endif
#define IN(k) (((PHASE_MASK >> (k)) & 1) && lo <= (k) && (k) < hi)
#ifndef PROBE_DUP
#define PROBE_DUP 0
#endif
#define DUP(k) ((PROBE_DUP >> (k)) & 1)
#define SEAM(k) do { if (IN(k) && IN((k) + 1)) xcd_barrier(bar); } while (0)

    if (IN(0)) { p0_prologue(F); if (DUP(0)) { __syncthreads(); p0_prologue(F); } } SEAM(0);
    if (IN(1)) { ph1(F); if (DUP(1)) ph1(F); } SEAM(1);
    if (IN(2)) { ph2(F); if (DUP(2)) ph2(F); } SEAM(2);
    if (IN(3)) { p3_state_scan(F); if (DUP(3)) p3_state_scan(F); } SEAM(3);
    if (IN(4)) {
#ifndef NO_ATT
        for (int rep_ = 0; rep_ < 1 + DUP(12); ++rep_) ph4a(F, (char*)lds);
#else
        { u32x4* yb = (u32x4*)(F.ws + WS_YB); for (int i = (F.vcu * NWAVES + F.wave) * 64 + F.lane; i < S_ * BW / 8; i += F.G * NTHR) yb[i] = (u32x4){0u, 0u, 0u, 0u}; }
#endif
#ifndef NO_ML
        ph4b(F); if (DUP(13)) ph4b(F);
#endif
    } SEAM(4);
    if (IN(5)) { ph5(F); if (DUP(5)) ph5(F); } SEAM(5);
    if (IN(6)) { ph6(F); if (DUP(6)) ph6(F); } SEAM(6);
    if (IN(7)) { p7_router(F); if (DUP(7)) p7_router(F); } SEAM(7);
    if (IN(8)) { p8_scatter(F); if (DUP(8)) p8_scatter(F); } SEAM(8);
    if (IN(9)) { ph9(F); if (DUP(9)) ph9(F); } SEAM(9);
    if (IN(10)) { ph10(F); if (DUP(10)) ph10(F); } SEAM(10);
    if (IN(11)) { p11_final(F); if (DUP(11)) p11_final(F); }
    if (DUP(14)) { for (int i_ = 0; i_ < 20; ++i_) xcd_barrier(bar); }
#undef IN
#undef SEAM
}

extern "C" void kernel_launch(void* const* d_in, const int* in_sizes, int n_in, void* d_out, int out_size, void* d_ws, size_t ws_size, hipStream_t stream) {
    static int grid = 0;
    if (grid == 0) {
        if (n_in != 20 || in_sizes[0] != S_ * DM || out_size != S_ * DM || ws_size < WS_END) { fprintf(stderr, "kernel_launch: unexpected shapes (n_in %d, in0 %d, out %d, ws %zu < %zu)\n", n_in, n_in > 0 ? in_sizes[0] : -1, out_size, ws_size, (size_t)WS_END); grid = -1; return; }
        int dev = 0, cus = 0, per_cu = 0;
        if (hipGetDevice(&dev) != hipSuccess || hipDeviceGetAttribute(&cus, hipDeviceAttributeMultiprocessorCount, dev) != hipSuccess) { grid = -1; return; }
        if (hipFuncSetAttribute((const void*)fwd_kernel, hipFuncAttributeMaxDynamicSharedMemorySize, LDS_BYTES) != hipSuccess) { fprintf(stderr, "kernel_launch: hipFuncSetAttribute failed\n"); grid = -1; return; }
        if (hipOccupancyMaxActiveBlocksPerMultiprocessor(&per_cu, (const void*)fwd_kernel, NTHR, LDS_BYTES) != hipSuccess || per_cu < 1) fprintf(stderr, "kernel_launch: note: occupancy query reports %d\n", per_cu);
        (void)hipGetLastError();
        grid = cus;
        if (grid != 256) { fprintf(stderr, "kernel_launch: built for the 256-CU MI355X (one workgroup per CU); found %d CUs\n", cus); grid = -1; return; }
    }
    if (grid < 0) return;
    if (hipMemsetAsync((char*)d_ws + WS_CTL, 0, CTL_ZERO_BYTES, stream) != hipSuccess) return;
    Args a{};
    for (int i = 0; i < 20; ++i) a.in[i] = (const float*)d_in[i];
    a.out = (float*)d_out; a.ws = (unsigned char*)d_ws;
#ifndef MK_PER_PHASE
#define MK_PER_PHASE 0
#endif
#if MK_PER_PHASE
    for (int p = 0; p < N_PHASES; ++p) { a.ph_lo = p; a.ph_hi = p + 1; hipLaunchKernelGGL(fwd_kernel, dim3(grid), dim3(NTHR), LDS_BYTES, stream, a); }
#else
    a.ph_lo = 0; a.ph_hi = N_PHASES; hipLaunchKernelGGL(fwd_kernel, dim3(grid), dim3(NTHR), LDS_BYTES, stream, a);
#endif
    const hipError_t le = hipPeekAtLastError();
    if (le != hipSuccess) fprintf(stderr, "kernel_launch: launch failed: %s\n", hipGetErrorName(le));
}
```
